# Optimizing an MI355X kernel written in HIP

```python
import math
import jax, jax.numpy as jnp
from jax import lax
import numpy as np

D_MODEL = 2048
BATCH = 1
SEQ = 8192
DEPTH = 2

N_A_LAYERS = DEPTH // 2
N_B_LAYERS = DEPTH - N_A_LAYERS

A_HEAD_DIM = 64
A_HEADS = D_MODEL // A_HEAD_DIM
A_KV_HEADS = A_HEADS // 8
A_WINDOW = 128
A_BLOCK = 128

B_HEAD_DIM = 128
B_HEADS = D_MODEL // B_HEAD_DIM
B_KV_HEADS = B_HEADS // 4
MOBA_BLOCK = 256
MOBA_TOPK = 3
MOBA_QCHUNK = 16

D_FF = 4 * D_MODEL

ROPE_THETA = 10000.0
LN_EPS = 1e-5
DEEPNORM_ALPHA = (2 * DEPTH) ** 0.25
DEEPNORM_BETA = (8 * DEPTH) ** -0.25

kernel_name = "yoco_swa_sink_moba_hybrid"


def layer_norm(x, g, b):
    xf = x.astype(jnp.float32)
    mu = jnp.mean(xf, axis=-1, keepdims=True)
    var = jnp.mean(jnp.square(xf - mu), axis=-1, keepdims=True)
    y = (xf - mu) * lax.rsqrt(var + LN_EPS)
    return (y * g.astype(jnp.float32) + b.astype(jnp.float32)).astype(x.dtype)


def rope(x, positions):
    d = x.shape[-1]
    half = d // 2
    inv_freq = ROPE_THETA ** (-(jnp.arange(half, dtype=jnp.float32) * 2.0) / d)
    ang = positions.astype(jnp.float32)[..., None] * inv_freq
    cos = jnp.cos(ang)[:, :, None, :]
    sin = jnp.sin(ang)[:, :, None, :]
    x1 = x[..., :half].astype(jnp.float32)
    x2 = x[..., half:].astype(jnp.float32)
    out = jnp.concatenate([x1 * cos - x2 * sin, x2 * cos + x1 * sin], axis=-1)
    return out.astype(x.dtype)


def mixer_a(h, positions, w_qkv, b_qkv, sinks, w_o):
    B, S, _ = h.shape
    G = A_HEADS // A_KV_HEADS
    nq = A_HEADS * A_HEAD_DIM
    nk = A_KV_HEADS * A_HEAD_DIM
    qkv = h @ w_qkv + b_qkv
    q = rope(qkv[..., :nq].reshape(B, S, A_HEADS, A_HEAD_DIM), positions)
    k = rope(qkv[..., nq:nq + nk].reshape(B, S, A_KV_HEADS, A_HEAD_DIM), positions)
    v = qkv[..., nq + nk:].reshape(B, S, A_KV_HEADS, A_HEAD_DIM)

    nb = S // A_BLOCK
    qb = q.reshape(B, nb, A_BLOCK, A_KV_HEADS, G, A_HEAD_DIM)
    pad = ((0, 0), (A_BLOCK, 0), (0, 0), (0, 0))
    kp = jnp.pad(k, pad)
    vp = jnp.pad(v, pad)
    kband = jnp.concatenate([kp[:, :S].reshape(B, nb, A_BLOCK, A_KV_HEADS, A_HEAD_DIM),
                             k.reshape(B, nb, A_BLOCK, A_KV_HEADS, A_HEAD_DIM)], axis=2)
    vband = jnp.concatenate([vp[:, :S].reshape(B, nb, A_BLOCK, A_KV_HEADS, A_HEAD_DIM),
                             v.reshape(B, nb, A_BLOCK, A_KV_HEADS, A_HEAD_DIM)], axis=2)

    s = jnp.einsum('bnqkgd,bnjkd->bnkgqj', qb, kband).astype(jnp.float32) * (A_HEAD_DIM ** -0.5)
    qi = jnp.arange(A_BLOCK)[:, None]
    kj = jnp.arange(2 * A_BLOCK)[None, :]
    rel = qi + A_BLOCK - kj
    in_win = (rel >= 0) & (rel < A_WINDOW)
    kpos = jnp.arange(nb)[:, None] * A_BLOCK - A_BLOCK + jnp.arange(2 * A_BLOCK)[None, :]
    mask = in_win[None] & (kpos >= 0)[:, None, :]
    s = jnp.where(mask[None, :, None, None], s, -jnp.inf)
    sink = jnp.broadcast_to(
        sinks.astype(jnp.float32).reshape(A_KV_HEADS, G)[None, None, :, :, None, None],
        s.shape[:-1] + (1,))
    p = jax.nn.softmax(jnp.concatenate([s, sink], axis=-1), axis=-1)[..., :-1]
    p = p.astype(v.dtype)
    o = jnp.einsum('bnkgqj,bnjkd->bnqkgd', p, vband).reshape(B, S, A_HEADS * A_HEAD_DIM)
    return o @ w_o


def moba_shared_kv(h, positions, w_kv):
    B, S, _ = h.shape
    nk = B_KV_HEADS * B_HEAD_DIM
    kv = h @ w_kv
    k = rope(kv[..., :nk].reshape(B, S, B_KV_HEADS, B_HEAD_DIM), positions)
    v = kv[..., nk:].reshape(B, S, B_KV_HEADS, B_HEAD_DIM)
    Sp = -(-S // MOBA_BLOCK) * MOBA_BLOCK
    pad = ((0, 0), (0, Sp - S), (0, 0), (0, 0))
    k = jnp.pad(k, pad)
    v = jnp.pad(v, pad)
    nb = Sp // MOBA_BLOCK
    kb = k.reshape(B, nb, MOBA_BLOCK, B_KV_HEADS, B_HEAD_DIM).transpose(0, 3, 1, 2, 4)
    vb = v.reshape(B, nb, MOBA_BLOCK, B_KV_HEADS, B_HEAD_DIM).transpose(0, 3, 1, 2, 4)
    kbar = jnp.mean(kb.astype(jnp.float32), axis=3).astype(k.dtype)
    return kb, vb, kbar


def mixer_b(h, positions, w_q, w_o, kb, vb, kbar):
    B, S, _ = h.shape
    nb = kb.shape[2]
    Sp = nb * MOBA_BLOCK
    G = B_HEADS // B_KV_HEADS
    q = rope((h @ w_q).reshape(B, S, B_HEADS, B_HEAD_DIM), positions)
    q = jnp.pad(q, ((0, 0), (0, Sp - S), (0, 0), (0, 0)))

    g = jnp.einsum('bskgd,bknd->bskgn', q.reshape(B, Sp, B_KV_HEADS, G, B_HEAD_DIM), kbar)
    g = g.astype(jnp.float32).reshape(B, Sp, B_HEADS, nb)
    qpos = jnp.arange(Sp)
    qblk = qpos // MOBA_BLOCK
    past = jnp.arange(nb)[None, :] < qblk[:, None]
    g = jnp.where(past[None, :, None, :], g, -jnp.inf)
    n_sel = min(MOBA_TOPK, nb)
    _, top_idx = lax.top_k(g, n_sel)
    own = jnp.broadcast_to(qblk[None, :, None, None], (B, Sp, B_HEADS, 1)).astype(top_idx.dtype)
    sel = jnp.concatenate([top_idx, own], axis=-1)
    NS = n_sel + 1
    is_own = jnp.arange(NS) == NS - 1

    nchunk = Sp // MOBA_QCHUNK
    q_ch = q.reshape(B, nchunk, MOBA_QCHUNK, B_HEADS, B_HEAD_DIM).swapaxes(0, 1)
    sel_ch = sel.reshape(B, nchunk, MOBA_QCHUNK, B_HEADS, NS).swapaxes(0, 1)
    pos_ch = qpos.reshape(nchunk, MOBA_QCHUNK)
    b_ix = jnp.arange(B)[:, None, None, None]
    kvh_ix = (jnp.arange(B_HEADS) // G)[None, None, :, None]
    scale = B_HEAD_DIM ** -0.5

    def attend(args):
        qc, sc, pc = args
        kg = kb[b_ix, kvh_ix, sc]
        vg = vb[b_ix, kvh_ix, sc]
        s = jnp.einsum('bqhd,bqhnjd->bqhnj', qc, kg).astype(jnp.float32) * scale
        kpos = sc[..., None] * MOBA_BLOCK + jnp.arange(MOBA_BLOCK)
        qp = pc[None, :, None, None, None]
        cb = (pc // MOBA_BLOCK)[None, :, None, None, None]
        valid = jnp.where(is_own[:, None], kpos <= qp, sc[..., None] < cb)
        s = jnp.where(valid, s, -jnp.inf)
        p = jax.nn.softmax(s.reshape(s.shape[:3] + (NS * MOBA_BLOCK,)), axis=-1)
        p = p.reshape(s.shape).astype(vg.dtype)
        return jnp.einsum('bqhnj,bqhnjd->bqhd', p, vg)

    o = lax.map(attend, (q_ch, sel_ch, pos_ch))
    o = o.swapaxes(0, 1).reshape(B, Sp, B_HEADS * B_HEAD_DIM)[:, :S]
    return o @ w_o


def sq_relu_mlp(h, w_in, w_out):
    return jnp.square(jax.nn.relu(h @ w_in)) @ w_out


def setup_inputs(seed: int = 0) -> dict:
    key = jax.random.key(seed)
    ks = jax.random.split(key, 20)

    def nrm(k, shape, fan_in, gain=1.0):
        return jax.random.normal(k, shape, jnp.float32) * (gain * fan_in ** -0.5)

    x = jax.random.normal(ks[0], (BATCH, SEQ, D_MODEL), jnp.float32)
    positions = jnp.broadcast_to(jnp.arange(SEQ, dtype=jnp.int32), (BATCH, SEQ))

    nq = A_HEADS * A_HEAD_DIM
    nk = A_KV_HEADS * A_HEAD_DIM
    a_wq = nrm(ks[1], (N_A_LAYERS, D_MODEL, nq), D_MODEL)
    a_wk = nrm(ks[2], (N_A_LAYERS, D_MODEL, nk), D_MODEL)
    a_wv = nrm(ks[3], (N_A_LAYERS, D_MODEL, nk), D_MODEL, DEEPNORM_BETA)
    a_w_qkv = jnp.concatenate([a_wq, a_wk, a_wv], axis=-1)
    a_b_qkv = 0.02 * jax.random.normal(ks[4], (N_A_LAYERS, nq + 2 * nk), jnp.float32)
    a_sinks = jax.random.normal(ks[5], (N_A_LAYERS, A_HEADS), jnp.float32)
    a_w_o = nrm(ks[6], (N_A_LAYERS, nq, D_MODEL), nq, DEEPNORM_BETA)

    bq = B_HEADS * B_HEAD_DIM
    bk = B_KV_HEADS * B_HEAD_DIM
    b_w_q = nrm(ks[7], (N_B_LAYERS, D_MODEL, bq), D_MODEL)
    b_w_o = nrm(ks[8], (N_B_LAYERS, bq, D_MODEL), bq, DEEPNORM_BETA)
    b_w_kv = jnp.concatenate([nrm(ks[9], (D_MODEL, bk), D_MODEL),
                              nrm(ks[10], (D_MODEL, bk), D_MODEL, DEEPNORM_BETA)], axis=-1)

    ln_attn_g = 1.0 + 0.02 * jax.random.normal(ks[11], (DEPTH, D_MODEL), jnp.float32)
    ln_attn_b = 0.02 * jax.random.normal(ks[12], (DEPTH, D_MODEL), jnp.float32)
    ln_mlp_g = 1.0 + 0.02 * jax.random.normal(ks[13], (DEPTH, D_MODEL), jnp.float32)
    ln_mlp_b = 0.02 * jax.random.normal(ks[14], (DEPTH, D_MODEL), jnp.float32)
    mlp_w_in = nrm(ks[15], (DEPTH, D_MODEL, D_FF), D_MODEL)
    mlp_w_out = nrm(ks[16], (DEPTH, D_FF, D_MODEL), D_FF, DEEPNORM_BETA)

    return {"x": x, "positions": positions,
            "a_w_qkv": a_w_qkv, "a_b_qkv": a_b_qkv, "a_sinks": a_sinks, "a_w_o": a_w_o,
            "b_w_q": b_w_q, "b_w_o": b_w_o, "b_w_kv": b_w_kv,
            "ln_attn_g": ln_attn_g, "ln_attn_b": ln_attn_b,
            "ln_mlp_g": ln_mlp_g, "ln_mlp_b": ln_mlp_b,
            "mlp_w_in": mlp_w_in, "mlp_w_out": mlp_w_out}


def reference(x, positions, a_w_qkv, a_b_qkv, a_sinks, a_w_o, b_w_q, b_w_o, b_w_kv,
              ln_attn_g, ln_attn_b, ln_mlp_g, ln_mlp_b, mlp_w_in, mlp_w_out):
    h = x
    kb = vb = kbar = None
    for layer in range(DEPTH):
        if layer < N_A_LAYERS:
            mix = mixer_a(h, positions, a_w_qkv[layer], a_b_qkv[layer], a_sinks[layer], a_w_o[layer])
        else:
            if layer == N_A_LAYERS:
                kb, vb, kbar = moba_shared_kv(h, positions, b_w_kv)
            bl = layer - N_A_LAYERS
            mix = mixer_b(h, positions, b_w_q[bl], b_w_o[bl], kb, vb, kbar)
        h = layer_norm(DEEPNORM_ALPHA * h + mix, ln_attn_g[layer], ln_attn_b[layer])
        h = layer_norm(DEEPNORM_ALPHA * h + sq_relu_mlp(h, mlp_w_in[layer], mlp_w_out[layer]),
                       ln_mlp_g[layer], ln_mlp_b[layer])
    return h
```

```cpp
#include <hip/hip_runtime.h>
#include <cstdio>
#include <cstdint>
namespace pg8 {
#define PG8_LAS __attribute__((address_space(3)))
typedef unsigned short bf16_t;
typedef short bf16x8 __attribute__((ext_vector_type(8)));
typedef float f32x4 __attribute__((ext_vector_type(4)));
typedef unsigned u32x4 __attribute__((ext_vector_type(4)));
constexpr int BM = 256, BK = 64, HALF = 128, HTB = HALF * BK * 2  , STAGE_BYTES = 8 * HTB, NXCD = 8, WGM = 8;

__host__ __device__ __forceinline__ int lds_byte(int r, int c) { const int st = (r >> 4) * 2 + (c >> 5), rr = r & 15, cc = c & 31, ob = rr * 64 + cc * 2; return st * 1024 + (ob ^ (((ob >> 9) & 1) << 5)); }
__host__ __device__ __forceinline__ void stage_rc(int b, int& R, int& C) { const int st = b / 1024, sb = b % 1024, swz = sb ^ (((sb >> 9) & 1) << 5); R = (st >> 1) * 16 + swz / 64; C = (st & 1) * 32 + (swz % 64) / 2; }
__host__ __device__ __forceinline__ int perm32(int rho) { const int n = rho >> 4, i = rho & 15; return 8 * (i >> 2) + 4 * n + (i & 3); }

struct Unit { int pm, pn; };
struct Gemm { const bf16_t* A; const bf16_t* Bt; int M, N, K; };

struct StaticOrder {
    int nM, nN, nwg, G, c;
    __host__ __device__ void init(int M, int N, int G_, int c_) { nM = M / BM; nN = N / BM; nwg = nM * nN; G = G_; c = c_; }
    __host__ __device__ bool next(int i, Unit& u) const {
        const long L = (long)i * G + c; if (L >= nwg) return false;
        int wgid = (int)L; { const int q = nwg / NXCD, r = nwg % NXCD, xcd = wgid % NXCD, off = wgid / NXCD; wgid = (xcd < r ? xcd * (q + 1) : r * (q + 1) + (xcd - r) * q) + off; }
        const int nig = WGM * nN, gid = wgid / nig, fm = gid * WGM, gsz = (nM - fm) < WGM ? (nM - fm) : WGM;
        u.pm = fm + ((wgid % nig) % gsz); u.pn = (wgid % nig) / gsz; return true;
    }
    __device__ __forceinline__ void a_ready(const Unit&) const {}
    __device__ __forceinline__ void done(const Unit&) const {}
};
__device__ __forceinline__ unsigned cvt_pk_bf16(float lo, float hi) { unsigned r; asm volatile("v_cvt_pk_bf16_f32 %0, %1, %2" : "=v"(r) : "v"(lo), "v"(hi)); return r; }
struct EpiF32 {
    static constexpr bool PERM = false, AFTER_DRAIN = false;
    float* C; int ldc;
    __device__ __forceinline__ void operator()(const f32x4 (&acc)[2][2][4][2], const Unit& u, int wr, int wc, int fr, int fq) const {
        const int row0 = u.pm * BM + wr * 64 + fr, col0 = u.pn * BM + wc * 32 + 4 * fq;
#pragma unroll
        for (int ai = 0; ai < 2; ++ai)
#pragma unroll
            for (int m = 0; m < 4; ++m) { float* rowp = C + (size_t)(row0 + ai * HALF + m * 16) * ldc + col0;
#pragma unroll
                for (int bj = 0; bj < 2; ++bj)
#pragma unroll
                    for (int n = 0; n < 2; ++n) *(f32x4*)(rowp + bj * HALF + n * 16) = acc[ai][bj][m][n]; }
    }
};
struct EpiRelu2 {
    static constexpr bool PERM = true, AFTER_DRAIN = false;
    bf16_t* O; int ldc;
    __device__ __forceinline__ void operator()(const f32x4 (&acc)[2][2][4][2], const Unit& u, int wr, int wc, int fr, int fq) const {
        const int row0 = u.pm * BM + wr * 64 + fr; const int col0 = u.pn * BM + wc * 32 + 8 * fq;
#pragma unroll
        for (int ai = 0; ai < 2; ++ai)
#pragma unroll
            for (int m = 0; m < 4; ++m) { bf16_t* rowp = O + (size_t)(row0 + ai * HALF + m * 16) * ldc + col0;
#pragma unroll
                for (int bj = 0; bj < 2; ++bj) { f32x4 v0 = acc[ai][bj][m][0], v1 = acc[ai][bj][m][1];
                    v0 = __builtin_elementwise_max(v0, (f32x4){0.f, 0.f, 0.f, 0.f}); v1 = __builtin_elementwise_max(v1, (f32x4){0.f, 0.f, 0.f, 0.f});
                    v0 = v0 * v0; v1 = v1 * v1;
                    u32x4 w; w.x = cvt_pk_bf16(v0[0], v0[1]); w.y = cvt_pk_bf16(v0[2], v0[3]); w.z = cvt_pk_bf16(v1[0], v1[1]); w.w = cvt_pk_bf16(v1[2], v1[3]);
                    *(u32x4*)(rowp + bj * HALF) = w; } }
    }
};

template <class Epi, class Sched, bool ALIGN_EPI = false, bool SP2 = false>
__device__ __forceinline__ void gemm_phase(PG8_LAS unsigned char* lds, const Gemm g, const Sched& S, const Epi& E) {
    const int tid = threadIdx.x, wid = __builtin_amdgcn_readfirstlane(tid >> 6), lane = tid & 63, wr = wid >> 2, wc = wid & 3, fr = lane & 15, fq = lane >> 4;
    const int K = g.K, nt = K / BK;
    unsigned voffA[2], voffB[2];
#pragma unroll
    for (int i = 0; i < 2; ++i) { int R, C; stage_rc(tid * 16 + i * 8192, R, C); const int Rb = Epi::PERM ? ((R & ~31) + perm32(R & 31)) : R;
        voffA[i] = (unsigned)(R * K + C) * 2u; voffB[i] = (unsigned)(Rb * K + C) * 2u; }
    const size_t kstep = (size_t)(BK * 2);
    const size_t hstep = (size_t)HALF * K * 2;
    const size_t tstep = 2 * hstep;
    const unsigned ldsw = (unsigned)wid * 1024u;
    const int aoff = lds_byte(wr * 64 + fr, fq * 8), boff = lds_byte(wc * 32 + fr, fq * 8);
#define PG8_SA(b, h) (((b) * 2 + (h)) * HTB)
#define PG8_SB(b, h) ((4 + (b) * 2 + (h)) * HTB)
#define PG8_STAGE(bufoff, gbase, voff) do { _Pragma("unroll") for (int _i = 0; _i < 2; ++_i) \
        __builtin_amdgcn_global_load_lds((const unsigned*)((const char*)(gbase) + (voff)[_i]), (PG8_LAS unsigned*)(lds + (bufoff) + ldsw + _i * 8192), 16, 0, 0); } while (0)
#define PG8_LDA(dst, b, h) do { _Pragma("unroll") for (int m = 0; m < 4; ++m) _Pragma("unroll") for (int k = 0; k < 2; ++k) dst[m][k] = *(const PG8_LAS bf16x8*)(lds + PG8_SA(b, h) + aoff + m * 2048 + k * 1024); } while (0)
#define PG8_LDB(dst, b, h) do { _Pragma("unroll") for (int n = 0; n < 2; ++n) _Pragma("unroll") for (int k = 0; k < 2; ++k) dst[n][k] = *(const PG8_LAS bf16x8*)(lds + PG8_SB(b, h) + boff + n * 2048 + k * 1024); } while (0)
#define PG8_MMA(ai, bj, At, Bt) do { __builtin_amdgcn_s_setprio(1); _Pragma("unroll") for (int m = 0; m < 4; ++m) _Pragma("unroll") for (int n = 0; n < 2; ++n) _Pragma("unroll") for (int k = 0; k < 2; ++k) \
        acc[ai][bj][m][n] = __builtin_amdgcn_mfma_f32_16x16x32_bf16(Bt[n][k], At[m][k], acc[ai][bj][m][n], 0, 0, 0); __builtin_amdgcn_s_setprio(0); } while (0)
#define PG8_WAIT_V(n) asm volatile("s_waitcnt vmcnt(" #n ")" ::: "memory")
#define PG8_WAIT_L(n) asm volatile("s_waitcnt lgkmcnt(" #n ")" ::: "memory")
#define PG8_BAR __builtin_amdgcn_s_barrier()
#define PG8_SCHED __builtin_amdgcn_sched_barrier(0)
    Unit cur, nxt; int ui = 0;
    if (!S.next(0, cur)) return;
    f32x4 acc[2][2][4][2];
#pragma unroll
    for (int a = 0; a < 2; ++a)
#pragma unroll
        for (int b = 0; b < 2; ++b)
#pragma unroll
            for (int m = 0; m < 4; ++m)
#pragma unroll
                for (int n = 0; n < 2; ++n) acc[a][b][m][n] = (f32x4){0.f, 0.f, 0.f, 0.f};
    bf16x8 At[4][2], B0[2][2], B1[2][2];
    const char* cA = (const char*)g.A + (size_t)cur.pm * tstep; const char* cB = (const char*)g.Bt + (size_t)cur.pn * tstep;
    S.a_ready(cur);
    if constexpr (SP2) {
        PG8_STAGE(PG8_SB(0, 0), cB, voffB); PG8_STAGE(PG8_SB(0, 1), cB + hstep, voffB); PG8_STAGE(PG8_SA(0, 0), cA, voffA); PG8_STAGE(PG8_SA(0, 1), cA + hstep, voffA);
        if (wr == 1) PG8_BAR;
        PG8_WAIT_V(2); PG8_BAR;
        PG8_STAGE(PG8_SB(1, 0), cB + kstep, voffB); PG8_STAGE(PG8_SA(1, 0), cA + kstep, voffA); PG8_STAGE(PG8_SB(1, 1), cB + hstep + kstep, voffB);
        PG8_WAIT_V(6); PG8_BAR;
    } else {
        PG8_STAGE(PG8_SB(0, 0), cB, voffB); PG8_STAGE(PG8_SA(0, 0), cA, voffA); PG8_STAGE(PG8_SB(0, 1), cB + hstep, voffB); PG8_STAGE(PG8_SA(0, 1), cA + hstep, voffA);
        if (wr == 1) PG8_BAR;
        PG8_WAIT_V(4); PG8_BAR;
        PG8_STAGE(PG8_SB(1, 0), cB + kstep, voffB); PG8_STAGE(PG8_SA(1, 0), cA + kstep, voffA); PG8_STAGE(PG8_SB(1, 1), cB + hstep + kstep, voffB);
        PG8_WAIT_V(6); PG8_BAR;
    }
    for (;;) {
        const bool has_next = S.next(ui + 1, nxt);
        const char* nA = has_next ? (const char*)g.A + (size_t)nxt.pm * tstep : cA; const char* nB = has_next ? (const char*)g.Bt + (size_t)nxt.pn * tstep : cB;
        for (int t = 0; t < nt; t += 2) {
            const bool last = (t == nt - 2);
            const char* a1 = cA + (size_t)(t + 1) * kstep;
            const char* a2 = last ? nA : cA + (size_t)(t + 2) * kstep; const char* b2 = last ? nB : cB + (size_t)(t + 2) * kstep;
            const char* a3 = a2 + kstep; const char* b3 = b2 + kstep;
            if (last && has_next) S.a_ready(nxt);
            if constexpr (SP2) {
            PG8_LDB(B0, 0, 0); PG8_LDB(B1, 0, 1); PG8_SCHED; PG8_LDA(At, 0, 0); PG8_STAGE(PG8_SA(1, 1), a1 + hstep, voffA);
            PG8_WAIT_V(8); PG8_WAIT_L(0); PG8_BAR; PG8_MMA(0, 0, At, B0); PG8_MMA(0, 1, At, B1); PG8_BAR; PG8_SCHED;
            PG8_LDA(At, 0, 1); PG8_STAGE(PG8_SB(0, 0), b2, voffB); PG8_STAGE(PG8_SB(0, 1), b2 + hstep, voffB); PG8_STAGE(PG8_SA(0, 0), a2, voffA);
            PG8_WAIT_V(8); PG8_WAIT_L(0); PG8_BAR; PG8_MMA(1, 0, At, B0); PG8_MMA(1, 1, At, B1); PG8_BAR; PG8_SCHED;
            PG8_LDB(B0, 1, 0); PG8_LDB(B1, 1, 1); PG8_SCHED; PG8_LDA(At, 1, 0); PG8_STAGE(PG8_SA(0, 1), a2 + hstep, voffA);
            PG8_WAIT_V(8); PG8_WAIT_L(0); PG8_BAR; PG8_MMA(0, 0, At, B0); PG8_MMA(0, 1, At, B1); PG8_BAR; PG8_SCHED;
            PG8_LDA(At, 1, 1); PG8_STAGE(PG8_SB(1, 0), b3, voffB); PG8_STAGE(PG8_SB(1, 1), b3 + hstep, voffB); PG8_STAGE(PG8_SA(1, 0), a3, voffA);
            PG8_WAIT_V(8); PG8_WAIT_L(0); PG8_BAR; PG8_MMA(1, 0, At, B0); PG8_MMA(1, 1, At, B1); PG8_BAR; PG8_SCHED;
            } else {
            PG8_LDB(B0, 0, 0); PG8_SCHED; PG8_LDA(At, 0, 0); PG8_STAGE(PG8_SA(1, 1), a1 + hstep, voffA);
            PG8_WAIT_L(8); PG8_BAR; PG8_WAIT_L(0); PG8_MMA(0, 0, At, B0); PG8_BAR; PG8_SCHED;
            PG8_LDB(B1, 0, 1); PG8_STAGE(PG8_SB(0, 0), b2, voffB);
            PG8_BAR; PG8_WAIT_L(0); PG8_MMA(0, 1, At, B1); PG8_BAR;
            PG8_LDA(At, 0, 1); PG8_STAGE(PG8_SA(0, 0), a2, voffA);
            PG8_BAR; PG8_WAIT_L(0); PG8_MMA(1, 0, At, B0); PG8_BAR; PG8_SCHED;
            PG8_STAGE(PG8_SB(0, 1), b2 + hstep, voffB);
            PG8_WAIT_V(6); PG8_BAR; PG8_MMA(1, 1, At, B1); PG8_BAR;
            PG8_LDB(B0, 1, 0); PG8_SCHED; PG8_LDA(At, 1, 0); PG8_STAGE(PG8_SA(0, 1), a2 + hstep, voffA);
            PG8_WAIT_L(8); PG8_BAR; PG8_WAIT_L(0); PG8_MMA(0, 0, At, B0); PG8_BAR; PG8_SCHED;
            PG8_LDB(B1, 1, 1); PG8_STAGE(PG8_SB(1, 0), b3, voffB);
            PG8_BAR; PG8_WAIT_L(0); PG8_MMA(0, 1, At, B1); PG8_BAR;
            PG8_LDA(At, 1, 1); PG8_STAGE(PG8_SA(1, 0), a3, voffA);
            PG8_BAR; PG8_WAIT_L(0); PG8_MMA(1, 0, At, B0); PG8_BAR; PG8_SCHED;
            PG8_STAGE(PG8_SB(1, 1), b3 + hstep, voffB);
            PG8_WAIT_V(6); PG8_BAR; PG8_MMA(1, 1, At, B1); PG8_BAR;
            }
        }
        if constexpr (ALIGN_EPI) { if (wr == 0) PG8_BAR; }
        if constexpr (!Epi::AFTER_DRAIN) { E(acc, cur, wr, wc, fr, fq); S.done(cur); }
        if (!has_next) break;
#pragma unroll
        for (int a = 0; a < 2; ++a)
#pragma unroll
            for (int b = 0; b < 2; ++b)
#pragma unroll
                for (int m = 0; m < 4; ++m)
#pragma unroll
                    for (int n = 0; n < 2; ++n) acc[a][b][m][n] = (f32x4){0.f, 0.f, 0.f, 0.f};
        cur = nxt; cA = nA; cB = nB; ++ui;
        if constexpr (ALIGN_EPI) { if (wr == 1) PG8_BAR; }
    }
    PG8_WAIT_V(0);
    if constexpr (!ALIGN_EPI) { if (wr == 0) PG8_BAR; }
    PG8_BAR;
    if constexpr (Epi::AFTER_DRAIN) { E.fused(acc, cur, wr, wc, fr, fq, lds, wid, lane); S.done(cur); }
#undef PG8_SA
#undef PG8_SB
#undef PG8_STAGE
#undef PG8_LDA
#undef PG8_LDB
#undef PG8_MMA
#undef PG8_WAIT_V
#undef PG8_WAIT_L
#undef PG8_BAR
#undef PG8_SCHED
}
}
#define GAS __attribute__((address_space(1)))
#define LAS __attribute__((address_space(3)))
typedef unsigned short bf16;
typedef unsigned v4u __attribute__((ext_vector_type(4)));
typedef float f32x4 __attribute__((ext_vector_type(4)));
typedef short bf16x8 __attribute__((ext_vector_type(8)));
typedef GAS unsigned gu32;
typedef GAS unsigned long long gu64;
#define RLX_AGENT __ATOMIC_RELAXED, __HIP_MEMORY_SCOPE_AGENT
#define LDS_WAIT() asm volatile("s_waitcnt lgkmcnt(0)" ::: "memory")
#define VM_WAIT() asm volatile("s_waitcnt vmcnt(0)" ::: "memory")
__device__ __forceinline__ unsigned long long rt() { return __builtin_amdgcn_s_memrealtime(); }
__device__ __forceinline__ unsigned f2bf(float f) { unsigned u = __builtin_bit_cast(unsigned, f); return (u + 0x7fffu + ((u >> 16) & 1u)) >> 16; }
__device__ __forceinline__ unsigned pk2(float lo, float hi) { return f2bf(lo) | (f2bf(hi) << 16); }

#define XB_TMO      128
#define XB_XCNT(j)  (256  + 64 * (j))
#define XB_XSUB(j)  (1280 + 64 * (j))
#define XB_XGEN(j)  (2304 + 64 * (j))
#define XB_TOP      3328
#define XB_TOPGEN   3392
#define XCD_BAR_WORDS 3456
#define XB_SPIN_CAP (1u << 24)

__device__ __forceinline__ unsigned xb_ld(unsigned* p)              { return __hip_atomic_load(p, __ATOMIC_RELAXED, __HIP_MEMORY_SCOPE_AGENT); }
__device__ __forceinline__ unsigned xb_add(unsigned* p, unsigned v) { return __hip_atomic_fetch_add(p, v, __ATOMIC_RELAXED, __HIP_MEMORY_SCOPE_AGENT); }
__device__ __forceinline__ unsigned xb_xcc_id() { return (unsigned)__builtin_amdgcn_s_getreg((3 << 11) | 20) & 0xFu; }
#define XB_SPIN(cond, bar) do { unsigned _sp = 0; while (cond) { __builtin_amdgcn_s_sleep(1); \
    if ((++_sp & 255u) == 0u) { if (xb_ld(&(bar)[XB_TMO])) break; if (_sp > XB_SPIN_CAP) { atomicAdd(&(bar)[XB_TMO], 1u); break; } } } } while (0)

struct XcdBarrier {
    unsigned* bar; unsigned x;
    volatile LAS unsigned* st;
};

__device__ __forceinline__ XcdBarrier xcd_barrier_post(unsigned* bar, volatile LAS unsigned* st) {
    XcdBarrier b; b.bar = bar; b.x = xb_xcc_id(); b.st = st;
    if (threadIdx.x == 0) (void)xb_add(&bar[XB_XCNT(b.x)], 1u);
    return b;
}
__device__ __forceinline__ void xcd_barrier_complete(unsigned* bar, unsigned x, unsigned& nloc, unsigned& nx) {
    const unsigned G = gridDim.x * gridDim.y * gridDim.z;
    unsigned sum, cnt, mine, sp = 0u;
    for (;;) {
        sum = 0u; cnt = 0u; mine = 0u;
#pragma unroll
        for (unsigned j = 0; j < 16; ++j) { const unsigned c = xb_ld(&bar[XB_XCNT(j)]); sum += c; cnt += (c > 0u) ? 1u : 0u; mine = (j == x) ? c : mine; }
        if (sum == G) break;
        __builtin_amdgcn_s_sleep(1);
        if ((++sp & 255u) == 0u) { if (xb_ld(&bar[XB_TMO])) break; if (sp > XB_SPIN_CAP) { atomicAdd(&bar[XB_TMO], 1u); break; } }
    }
    nloc = mine > 0u ? mine : 1u; nx = cnt > 0u ? cnt : 1u;
}

__device__ __forceinline__ void xcd_barrier(const XcdBarrier& b) {
    asm volatile("s_waitcnt vmcnt(0)" ::: "memory");
    __syncthreads();
    if (threadIdx.x == 0) {
        unsigned* bar = b.bar;
        __builtin_amdgcn_s_waitcnt(0);
        unsigned nloc = b.st[0], nx = b.st[1];
        if (nloc == 0u) { xcd_barrier_complete(bar, b.x, nloc, nx); b.st[0] = nloc; b.st[1] = nx; }
        const unsigned old = xb_add(&bar[XB_XSUB(b.x)], 1u);
        const unsigned gen = old / nloc;
        if (old + 1u == (gen + 1u) * nloc) {
            __builtin_amdgcn_fence(__ATOMIC_RELEASE, "agent");
            asm volatile("s_waitcnt vmcnt(0)" ::: "memory");
            const unsigned og = xb_add(&bar[XB_TOP], 1u);
            const unsigned tg = og / nx;
            if (og + 1u == (tg + 1u) * nx) xb_add(&bar[XB_TOPGEN], 1u);
            else XB_SPIN(xb_ld(&bar[XB_TOPGEN]) == tg, bar);
            __builtin_amdgcn_fence(__ATOMIC_ACQUIRE, "agent");
            xb_add(&bar[XB_XGEN(b.x)], 1u);
            asm volatile("s_waitcnt vmcnt(0)" ::: "memory");
        } else {
            XB_SPIN(xb_ld(&bar[XB_XGEN(b.x)]) == gen, bar);
            __builtin_amdgcn_fence(__ATOMIC_ACQUIRE, "agent");
            asm volatile("s_waitcnt vmcnt(0)" ::: "memory");
        }
    }
    __syncthreads();
}
constexpr int S = 8192, D = 2048, FF = 8192;
constexpr int A_H = 32, A_HD = 64, A_KV = 4, A_NQKV = 2560, A_WIN = 128;
constexpr int B_H = 16, B_HD = 128, B_KV = 4, B_NQKV = 3072, MB = 256, NBLK = S / MB;
constexpr float ALPHA = 1.4142135623730951f, LN_EPS = 1e-5f, LOG2E = 1.4426950408889634f;
constexpr float QS_A = 0.125f * LOG2E;
constexpr float QS_B = 0.08838834764831845f * LOG2E;
constexpr int NWAVES = 8, NTHR = 512;

constexpr size_t MiB = 1u << 20;
constexpr size_t WS_CTL = 0, CTL_ZERO_BYTES = 1 * MiB;
constexpr size_t WS_COSA = 1 * MiB, WS_SINA = 2 * MiB, WS_COSB = 3 * MiB, WS_SINB = 5 * MiB, WS_KBAR = 7 * MiB;
constexpr size_t WS_WQKV = 8 * MiB, WS_WO = 18 * MiB, WS_W1 = 26 * MiB  , WS_W2 = 90 * MiB  , WS_WQKVB = 154 * MiB, WS_WOB = 166 * MiB;
constexpr size_t WS_XB = 174 * MiB;
constexpr size_t WS_R = 206 * MiB;
constexpr size_t WS_Q = WS_R + 96 * MiB;
constexpr size_t WS_O = 334 * MiB;
constexpr size_t WS_K = 366 * MiB, WS_V = 370 * MiB;
constexpr size_t WS_KB = 374 * MiB, WS_VB = 382 * MiB;
constexpr size_t WS_C = 390 * MiB;
constexpr size_t WS_END = 486 * MiB;
constexpr int CW_TMO = 0, CW_BAR = 4096;

constexpr int RING_OFF = 0, RING_BYTES = 131072;
constexpr int LDSCTL_OFF = RING_BYTES, MISC_OFF = LDSCTL_OFF + 320;
constexpr int LDS_BYTES = 147456;

__device__ __forceinline__ float wave_sum(float v) {
#pragma unroll
    for (int o = 1; o < 64; o <<= 1) v += __shfl_xor(v, o);
    return v;
}
__device__ __forceinline__ void p0_transpose_item(const float* W, int K, int N, bf16* WT, int row_off, LAS float* scr, int item, int lane) {
    const int nblk = N / 32, kb = item / nblk, nb = item % nblk, k0 = 64 * kb, n0 = 32 * nb;
#pragma unroll 8
    for (int i = 0; i < 32; ++i) { const int kk = 2 * i + (lane >> 5); scr[kk * 33 + (lane & 31)] = W[(size_t)(k0 + kk) * N + n0 + (lane & 31)]; }
    LDS_WAIT(); asm volatile("" ::: "memory");
    const int c = lane & 7;
#pragma unroll
    for (int j = 0; j < 4; ++j) { const int n = (lane >> 3) + 8 * j; const LAS float* s = scr + (8 * c) * 33 + n;
        v4u o; o.x = pk2(s[0 * 33], s[1 * 33]); o.y = pk2(s[2 * 33], s[3 * 33]); o.z = pk2(s[4 * 33], s[5 * 33]); o.w = pk2(s[6 * 33], s[7 * 33]);
        *(GAS v4u*)(WT + (size_t)(row_off + n0 + n) * K + k0 + 8 * c) = o; }
    LDS_WAIT(); asm volatile("" ::: "memory");
}
struct Ctx { LAS unsigned char* lds; int tid, lane, wave, vcu, G; };

__device__ __forceinline__ void p0_prologue(const Ctx& c, const float* const* in, unsigned char* ws) {
    LAS float* scr = (LAS float*)(c.lds + RING_OFF + c.wave * 16384);
    const int gw = c.vcu * NWAVES + c.wave, NGW = c.G * NWAVES;
    constexpr int I_QKV = (D / 64) * (A_NQKV / 32), I_SQ = (D / 64) * (D / 32), I_KV = (D / 64) * (1024 / 32), I_W1 = (D / 64) * (FF / 32), I_W2 = (FF / 64) * (D / 32);
    constexpr int NITEMS = I_QKV + 3 * I_SQ + I_KV + 2 * I_W1 + 2 * I_W2;
    for (int it = gw; it < NITEMS; it += NGW) {
        int r = it;
        if (r < I_QKV) { p0_transpose_item(in[2], D, A_NQKV, (bf16*)(ws + WS_WQKV), 0, scr, r, c.lane); continue; } r -= I_QKV;
        if (r < I_SQ) { p0_transpose_item(in[5], D, D, (bf16*)(ws + WS_WO), 0, scr, r, c.lane); continue; } r -= I_SQ;
        if (r < I_SQ) { p0_transpose_item(in[6], D, D, (bf16*)(ws + WS_WQKVB), 0, scr, r, c.lane); continue; } r -= I_SQ;
        if (r < I_KV) { p0_transpose_item(in[8], D, 1024, (bf16*)(ws + WS_WQKVB), D, scr, r, c.lane); continue; } r -= I_KV;
        if (r < I_SQ) { p0_transpose_item(in[7], D, D, (bf16*)(ws + WS_WOB), 0, scr, r, c.lane); continue; } r -= I_SQ;
        if (r < I_W1) { p0_transpose_item(in[13], D, FF, (bf16*)(ws + WS_W1), 0, scr, r, c.lane); continue; } r -= I_W1;
        if (r < I_W1) { p0_transpose_item(in[13] + (size_t)D * FF, D, FF, (bf16*)(ws + WS_W1 + 32 * MiB), 0, scr, r, c.lane); continue; } r -= I_W1;
        if (r < I_W2) { p0_transpose_item(in[14], FF, D, (bf16*)(ws + WS_W2), 0, scr, r, c.lane); continue; } r -= I_W2;
        p0_transpose_item(in[14] + (size_t)D * FF, FF, D, (bf16*)(ws + WS_W2 + 32 * MiB), 0, scr, r, c.lane);
    }
    const int gt = c.vcu * NTHR + c.tid, NGT = c.G * NTHR;
    { const f32x4* x4 = (const f32x4*)in[0]; v4u* o = (v4u*)(ws + WS_XB);
      for (int i = gt; i < S * D / 8; i += NGT) { const f32x4 a = x4[2 * i], b = x4[2 * i + 1]; v4u w; w.x = pk2(a[0], a[1]); w.y = pk2(a[2], a[3]); w.z = pk2(b[0], b[1]); w.w = pk2(b[2], b[3]); o[i] = w; } }
    { const int* pos = (const int*)in[1]; float* cA = (float*)(ws + WS_COSA); float* sA = (float*)(ws + WS_SINA); float* cB = (float*)(ws + WS_COSB); float* sB = (float*)(ws + WS_SINB);
      for (int i = gt; i < S * 96; i += NGT) { const int s = i / 96, j = i % 96; const bool isA = j < 32; const int fi = isA ? j : j - 32; const double dd = isA ? 64.0 : 128.0;
          const double invf = exp2(-(double)(2 * fi) / dd * 13.287712379549449); const double ang = (double)pos[s] * invf;
          double t = ang * 0.15915494309189535; t -= rint(t); const double r = t * 6.283185307179586;
          const float cv = (float)cos(r), sv = (float)sin(r);
          if (isA) { cA[s * 32 + fi] = cv; sA[s * 32 + fi] = sv; } else { cB[s * 64 + fi] = cv; sB[s * 64 + fi] = sv; } } }
}

__device__ __forceinline__ void p_rope_a(const Ctx& c, const float* C, const float* bias, unsigned char* ws) {
    const int gt = c.vcu * NTHR + c.tid, NGT = c.G * NTHR;
    const float* cA = (const float*)(ws + WS_COSA); const float* sA = (const float*)(ws + WS_SINA);
    bf16* Q = (bf16*)(ws + WS_Q); bf16* K = (bf16*)(ws + WS_K); bf16* V = (bf16*)(ws + WS_V);
    for (int idx = gt; idx < S * 1280; idx += NGT) {
        const int s = idx / 1280, p = idx % 1280; const float* Cr = C + (size_t)s * A_NQKV;
        if (p < 1152) { const int h = p >> 5, d = p & 31; const int c0 = h * 64 + d;
            const float x1 = Cr[c0] + bias[c0], x2 = Cr[c0 + 32] + bias[c0 + 32]; const float cs = cA[s * 32 + d], sn = sA[s * 32 + d];
            float o1 = x1 * cs - x2 * sn, o2 = x2 * cs + x1 * sn;
            if (h < 32) { o1 *= QS_A; o2 *= QS_A; Q[(size_t)s * 2048 + c0] = (bf16)f2bf(o1); Q[(size_t)s * 2048 + c0 + 32] = (bf16)f2bf(o2); }
            else { const int kc = (h - 32) * 64 + d; K[(size_t)s * 256 + kc] = (bf16)f2bf(o1); K[(size_t)s * 256 + kc + 32] = (bf16)f2bf(o2); }
        } else { const int v0 = (p - 1152) * 2; const int c0 = 2304 + v0;
            *(unsigned*)(V + (size_t)s * 256 + v0) = pk2(Cr[c0] + bias[c0], Cr[c0 + 1] + bias[c0 + 1]); }
    }
}
__device__ __forceinline__ void p_rope_b(const Ctx& c, const float* C, unsigned char* ws) {
    const int gt = c.vcu * NTHR + c.tid, NGT = c.G * NTHR;
    const float* cB = (const float*)(ws + WS_COSB); const float* sB = (const float*)(ws + WS_SINB);
    bf16* Q = (bf16*)(ws + WS_Q); bf16* K = (bf16*)(ws + WS_KB); bf16* V = (bf16*)(ws + WS_VB);
    for (int idx = gt; idx < S * 1536; idx += NGT) {
        const int s = idx / 1536, p = idx % 1536; const float* Cr = C + (size_t)s * B_NQKV;
        if (p < 1280) { const int h = p >> 6, d = p & 63; const int c0 = h * 128 + d;
            const float x1 = Cr[c0], x2 = Cr[c0 + 64]; const float cs = cB[s * 64 + d], sn = sB[s * 64 + d];
            float o1 = x1 * cs - x2 * sn, o2 = x2 * cs + x1 * sn;
            if (h < 16) { o1 *= QS_B; o2 *= QS_B; Q[(size_t)s * 2048 + c0] = (bf16)f2bf(o1); Q[(size_t)s * 2048 + c0 + 64] = (bf16)f2bf(o2); }
            else { const int kc = (h - 16) * 128 + d; K[(size_t)s * 512 + kc] = (bf16)f2bf(o1); K[(size_t)s * 512 + kc + 64] = (bf16)f2bf(o2); }
        } else { const int v0 = (p - 1280) * 2; const int c0 = 2560 + v0;
            *(unsigned*)(V + (size_t)s * 512 + v0) = pk2(Cr[c0], Cr[c0 + 1]); }
    }
}
__device__ __forceinline__ float bf2f(unsigned short b) { return __builtin_bit_cast(float, (unsigned)b << 16); }
__device__ __forceinline__ void unpack8(const v4u w, float* f) {
    f[0] = __builtin_bit_cast(float, w.x << 16); f[1] = __builtin_bit_cast(float, w.x & 0xffff0000u);
    f[2] = __builtin_bit_cast(float, w.y << 16); f[3] = __builtin_bit_cast(float, w.y & 0xffff0000u);
    f[4] = __builtin_bit_cast(float, w.z << 16); f[5] = __builtin_bit_cast(float, w.z & 0xffff0000u);
    f[6] = __builtin_bit_cast(float, w.w << 16); f[7] = __builtin_bit_cast(float, w.w & 0xffff0000u);
}
__device__ __forceinline__ void p_swa_naive(const Ctx& c, const float* sinks, unsigned char* ws) {
    const int gt = c.vcu * NTHR + c.tid, NGT = c.G * NTHR;
    const bf16* Q = (const bf16*)(ws + WS_Q); const bf16* K = (const bf16*)(ws + WS_K); const bf16* V = (const bf16*)(ws + WS_V); bf16* O = (bf16*)(ws + WS_O);
    for (int idx = gt; idx < S * A_H; idx += NGT) {
        const int s = idx >> 5, h = idx & 31, kvh = h >> 3;
        float q[64];
#pragma unroll
        for (int i = 0; i < 8; ++i) unpack8(*(const v4u*)(Q + (size_t)s * 2048 + h * 64 + 8 * i), q + 8 * i);
        float m = sinks[h] * LOG2E, l = 1.f; float o[64];
#pragma unroll
        for (int i = 0; i < 64; ++i) o[i] = 0.f;
        const int j0 = s - (A_WIN - 1) < 0 ? 0 : s - (A_WIN - 1);
        for (int j = j0; j <= s; ++j) {
            float sc = 0.f;
#pragma unroll
            for (int i = 0; i < 8; ++i) { float kf[8]; unpack8(*(const v4u*)(K + (size_t)j * 256 + kvh * 64 + 8 * i), kf);
#pragma unroll
                for (int e = 0; e < 8; ++e) sc += q[8 * i + e] * kf[e]; }
            const float mn = fmaxf(m, sc), corr = exp2f(m - mn), p = exp2f(sc - mn); m = mn; l = l * corr + p;
#pragma unroll
            for (int i = 0; i < 8; ++i) { float vf[8]; unpack8(*(const v4u*)(V + (size_t)j * 256 + kvh * 64 + 8 * i), vf);
#pragma unroll
                for (int e = 0; e < 8; ++e) o[8 * i + e] = o[8 * i + e] * corr + p * vf[e]; }
        }
        const float rl = 1.f / l;
#pragma unroll
        for (int i = 0; i < 8; ++i) { v4u w; w.x = pk2(o[8 * i] * rl, o[8 * i + 1] * rl); w.y = pk2(o[8 * i + 2] * rl, o[8 * i + 3] * rl); w.z = pk2(o[8 * i + 4] * rl, o[8 * i + 5] * rl); w.w = pk2(o[8 * i + 6] * rl, o[8 * i + 7] * rl);
            *(v4u*)(O + (size_t)s * 2048 + h * 64 + 8 * i) = w; }
    }
}
__device__ __forceinline__ void p_kbar(const Ctx& c, unsigned char* ws) {
    const int gt = c.vcu * NTHR + c.tid, NGT = c.G * NTHR;
    const bf16* K = (const bf16*)(ws + WS_KB); float* kbar = (float*)(ws + WS_KBAR);
    for (int idx = gt; idx < B_KV * NBLK * B_HD; idx += NGT) { const int d = idx & 127, n = (idx >> 7) & 31, kvh = idx >> 12; float a = 0.f;
        for (int r = 0; r < MB; ++r) a += bf2f(K[(size_t)(n * MB + r) * 512 + kvh * 128 + d]);
        kbar[idx] = a * (1.f / MB); }
}
__device__ __forceinline__ float wave_max(float v) {
#pragma unroll
    for (int o = 1; o < 64; o <<= 1) v = fmaxf(v, __shfl_xor(v, o));
    return v;
}
__device__ __forceinline__ void p_moba_naive(const Ctx& c, unsigned char* ws) {
    const int gw = c.vcu * NWAVES + c.wave, NGW = c.G * NWAVES, lane = c.lane;
    const bf16* Q = (const bf16*)(ws + WS_Q); const bf16* K = (const bf16*)(ws + WS_KB); const bf16* V = (const bf16*)(ws + WS_VB); bf16* O = (bf16*)(ws + WS_O);
    const float* kbar = (const float*)(ws + WS_KBAR);
    LAS float* qs = (LAS float*)(c.lds + c.wave * 8192); LAS float* ps = qs + 128;
    for (int task = gw; task < S * B_H; task += NGW) {
        const int s = task >> 4, h = task & 15, kvh = h >> 2, qb = s >> 8;
        { const unsigned w = *(const unsigned*)(Q + (size_t)s * 2048 + h * 128 + 2 * lane); qs[2 * lane] = __builtin_bit_cast(float, w << 16); qs[2 * lane + 1] = __builtin_bit_cast(float, w & 0xffff0000u); }
        LDS_WAIT(); asm volatile("" ::: "memory");
        float g = -INFINITY;
        if (lane < qb) { const float* kb = kbar + (size_t)(kvh * NBLK + lane) * 128; float a = 0.f; for (int d = 0; d < 128; ++d) a += qs[d] * kb[d]; g = a; }
        int sel[4];
#pragma unroll
        for (int r = 0; r < 3; ++r) { float bv = g; int bi = lane;
#pragma unroll
            for (int o = 1; o < 64; o <<= 1) { const float ov = __shfl_xor(bv, o); const int oi = __shfl_xor(bi, o); if (ov > bv || (ov == bv && oi < bi)) { bv = ov; bi = oi; } }
            sel[r] = (bv == -INFINITY) ? -1 : bi; if (lane == bi) g = -INFINITY; }
        sel[3] = qb;
        float sc[4][4]; float mx = -INFINITY;
#pragma unroll
        for (int b = 0; b < 4; ++b) {
#pragma unroll
            for (int t = 0; t < 4; ++t) { sc[b][t] = -INFINITY;
                if (sel[b] >= 0) { const int j = sel[b] * MB + lane + 64 * t; const bf16* kr = K + (size_t)j * 512 + kvh * 128; float a = 0.f;
                    for (int i = 0; i < 16; ++i) { float kf[8]; unpack8(*(const v4u*)(kr + 8 * i), kf);
#pragma unroll
                        for (int e = 0; e < 8; ++e) a += qs[8 * i + e] * kf[e]; }
                    if (b == 3 && j > s) a = -INFINITY; sc[b][t] = a; mx = fmaxf(mx, a); } } }
        mx = wave_max(mx); float ls = 0.f;
#pragma unroll
        for (int b = 0; b < 4; ++b)
#pragma unroll
            for (int t = 0; t < 4; ++t) { const float p = exp2f(sc[b][t] - mx); ls += p; ps[b * 256 + lane + 64 * t] = p; }
        ls = wave_sum(ls);
        LDS_WAIT(); asm volatile("" ::: "memory");
        float o0 = 0.f, o1 = 0.f;
#pragma unroll
        for (int b = 0; b < 4; ++b) { if (sel[b] < 0) continue; const bf16* vr = V + (size_t)(sel[b] * MB) * 512 + kvh * 128 + 2 * lane;
            for (int jj = 0; jj < MB; ++jj) { const float p = ps[b * 256 + jj]; const unsigned w = *(const unsigned*)(vr + (size_t)jj * 512);
                o0 += p * __builtin_bit_cast(float, w << 16); o1 += p * __builtin_bit_cast(float, w & 0xffff0000u); } }
        const float rl = 1.f / ls;
        *(unsigned*)(O + (size_t)s * 2048 + h * 128 + 2 * lane) = pk2(o0 * rl, o1 * rl);
        LDS_WAIT(); asm volatile("" ::: "memory");
    }
}
__device__ __forceinline__ void p_ln(const Ctx& c, const float* res, const float* C, const float* g, const float* b, float* out, bf16* xb) {
    const int gw = c.vcu * NWAVES + c.wave, NGW = c.G * NWAVES, lane = c.lane;
    for (int row = gw; row < S; row += NGW) {
        const f32x4* r4 = (const f32x4*)(res + (size_t)row * D) + lane; const f32x4* c4 = (const f32x4*)(C + (size_t)row * D) + lane;
        f32x4 v[8]; float sm = 0.f;
#pragma unroll
        for (int j = 0; j < 8; ++j) { v[j] = r4[64 * j] * ALPHA + c4[64 * j]; sm += (v[j][0] + v[j][1]) + (v[j][2] + v[j][3]); }
        const float mean = wave_sum(sm) * (1.f / D); float s2 = 0.f;
#pragma unroll
        for (int j = 0; j < 8; ++j) { v[j] = v[j] - mean; s2 += (v[j][0] * v[j][0] + v[j][1] * v[j][1]) + (v[j][2] * v[j][2] + v[j][3] * v[j][3]); }
        const float rstd = 1.f / sqrtf(wave_sum(s2) * (1.f / D) + LN_EPS);
        f32x4* o4 = (f32x4*)(out + (size_t)row * D) + lane; unsigned long long* o8 = (unsigned long long*)(xb + (size_t)row * D) + lane;
#pragma unroll
        for (int j = 0; j < 8; ++j) { const f32x4 gg = ((const f32x4*)g)[lane + 64 * j], bb = ((const f32x4*)b)[lane + 64 * j]; const f32x4 y = v[j] * rstd * gg + bb;
            o4[64 * j] = y; o8[64 * j] = (unsigned long long)pk2(y[0], y[1]) | ((unsigned long long)pk2(y[2], y[3]) << 32); }
    }
}

struct Args { const float* in[15]; float* out; unsigned char* ws; int ph_lo, ph_hi, li, pad; };
constexpr int N_PHASES = 18;
#ifndef MK_N_LAUNCHES
#define MK_N_LAUNCHES 18
#endif
__global__ void __launch_bounds__(NTHR, 2) fwd(Args args) {
    extern __shared__ __attribute__((aligned(16))) unsigned char lds[];
    Ctx c; c.lds = (LAS unsigned char*)lds; c.tid = threadIdx.x; c.lane = c.tid & 63; c.wave = __builtin_amdgcn_readfirstlane(c.tid >> 6);
    c.G = gridDim.x; { const int bx = blockIdx.x; c.vcu = (c.G % 8 == 0) ? (bx % 8) * (c.G / 8) + bx / 8 : bx; }
    volatile LAS unsigned* MISC = (volatile LAS unsigned*)(c.lds + MISC_OFF);
    unsigned char* ws = args.ws; gu32* ctl = (gu32*)(ws + WS_CTL);
    for (int u = c.tid; u < (LDS_BYTES - LDSCTL_OFF) / 4; u += NTHR) ((LAS unsigned*)(c.lds + LDSCTL_OFF))[u] = 0u;
    __syncthreads();
    XcdBarrier bar; bar.bar = (unsigned*)(ctl + CW_BAR) + args.li * XCD_BAR_WORDS; bar.x = 0; bar.st = nullptr;
    if (MK_N_LAUNCHES == 1) bar = xcd_barrier_post((unsigned*)(ctl + CW_BAR), MISC + 8);
    const int lo = args.ph_lo, hi = args.ph_hi;
#define IN(k) (lo <= (k) && (k) < hi)
#define SEAM(k) do { if (IN(k) && IN((k) + 1)) xcd_barrier(bar); } while (0)
    const float* const* in = args.in; float* out = args.out;
    float* C = (float*)(ws + WS_C); bf16* XB = (bf16*)(ws + WS_XB); bf16* HID = (bf16*)(ws + WS_R); bf16* OB = (bf16*)(ws + WS_O);
    typedef pg8::bf16_t pb;
#define GEMM_F32(Aptr, Bptr, Nn, Kk) do { pg8::Gemm g{(const pb*)(Aptr), (const pb*)(Bptr), S, (Nn), (Kk)}; pg8::StaticOrder So; So.init(S, (Nn), c.G, (int)blockIdx.x); pg8::EpiF32 E{C, (Nn)}; \
        pg8::gemm_phase<pg8::EpiF32, pg8::StaticOrder, true, true>(c.lds + RING_OFF, g, So, E); } while (0)
#define GEMM_RELU2(Aptr, Bptr, Nn, Kk) do { pg8::Gemm g{(const pb*)(Aptr), (const pb*)(Bptr), S, (Nn), (Kk)}; pg8::StaticOrder So; So.init(S, (Nn), c.G, (int)blockIdx.x); pg8::EpiRelu2 E{(pb*)HID, (Nn)}; \
        pg8::gemm_phase<pg8::EpiRelu2, pg8::StaticOrder, true, true>(c.lds + RING_OFF, g, So, E); } while (0)

    if (IN(0)) p0_prologue(c, in, ws);
    SEAM(0);
    if (IN(1)) GEMM_F32(XB, ws + WS_WQKV, A_NQKV, D);
    SEAM(1);
    if (IN(2)) p_rope_a(c, C, in[3], ws);
    SEAM(2);
    if (IN(3)) p_swa_naive(c, in[4], ws);
    SEAM(3);
    if (IN(4)) GEMM_F32(OB, ws + WS_WO, D, D);
    SEAM(4);
    if (IN(5)) p_ln(c, in[0], C, in[9], in[10], out, XB);
    SEAM(5);
    if (IN(6)) GEMM_RELU2(XB, ws + WS_W1, FF, D);
    SEAM(6);
    if (IN(7)) GEMM_F32(HID, ws + WS_W2, D, FF);
    SEAM(7);
    if (IN(8)) p_ln(c, out, C, in[11], in[12], out, XB);
    SEAM(8);
    if (IN(9)) GEMM_F32(XB, ws + WS_WQKVB, B_NQKV, D);
    SEAM(9);
    if (IN(10)) p_rope_b(c, C, ws);
    SEAM(10);
    if (IN(11)) p_kbar(c, ws);
    SEAM(11);
    if (IN(12)) p_moba_naive(c, ws);
    SEAM(12);
    if (IN(13)) GEMM_F32(OB, ws + WS_WOB, D, D);
    SEAM(13);
    if (IN(14)) p_ln(c, out, C, in[9] + D, in[10] + D, out, XB);
    SEAM(14);
    if (IN(15)) GEMM_RELU2(XB, ws + WS_W1 + 32 * MiB, FF, D);
    SEAM(15);
    if (IN(16)) GEMM_F32(HID, ws + WS_W2 + 32 * MiB, D, FF);
    SEAM(16);
    if (IN(17)) p_ln(c, out, C, in[11] + D, in[12] + D, out, XB);
#undef IN
#undef SEAM
}

extern "C" void kernel_launch(void* const* d_in, const int* in_sizes, int n_in, void* d_out, int out_size, void* d_ws, size_t ws_size, hipStream_t stream) {
    static int grid = 0;
    if (grid == 0) {
        if (n_in != 15 || out_size != S * D || ws_size < WS_END) { fprintf(stderr, "kernel_launch: unexpected sizes n_in %d out %d ws %zu\n", n_in, out_size, ws_size); grid = -1; return; }
        int dev = 0, cus = 0, per_cu = 0;
        if (hipGetDevice(&dev) != hipSuccess || hipDeviceGetAttribute(&cus, hipDeviceAttributeMultiprocessorCount, dev) != hipSuccess) { grid = -1; return; }
        if (hipFuncSetAttribute((const void*)fwd, hipFuncAttributeMaxDynamicSharedMemorySize, LDS_BYTES) != hipSuccess) { fprintf(stderr, "kernel_launch: hipFuncSetAttribute failed\n"); grid = -1; return; }
        if (hipOccupancyMaxActiveBlocksPerMultiprocessor(&per_cu, (const void*)fwd, NTHR, LDS_BYTES) != hipSuccess || per_cu < 1) { fprintf(stderr, "kernel_launch: occupancy query says %d\n", per_cu); }
        (void)hipGetLastError();
        grid = cus;
    }
    if (grid < 0) return;
    (void)hipMemsetAsync((char*)d_ws + WS_CTL, 0, CTL_ZERO_BYTES, stream);
    Args a{};
    for (int i = 0; i < 15; ++i) a.in[i] = (const float*)d_in[i];
    a.out = (float*)d_out; a.ws = (unsigned char*)d_ws;
    if (MK_N_LAUNCHES == 1) { a.ph_lo = 0; a.ph_hi = N_PHASES; a.li = 0; hipLaunchKernelGGL(fwd, dim3(grid), dim3(NTHR), LDS_BYTES, stream, a); }
    else { for (int p = 0; p < N_PHASES; ++p) { a.ph_lo = p; a.ph_hi = p + 1; a.li = 0; hipLaunchKernelGGL(fwd, dim3(grid), dim3(NTHR), LDS_BYTES, stream, a); } }
}
```

```cpp
#include <hip/hip_runtime.h>
#include <cstdio>
#include <cstdint>
namespace pg8 {
#define PG8_LAS __attribute__((address_space(3)))
typedef unsigned short bf16_t;
typedef short bf16x8 __attribute__((ext_vector_type(8)));
typedef float f32x4 __attribute__((ext_vector_type(4)));
typedef unsigned u32x4 __attribute__((ext_vector_type(4)));
constexpr int BM = 256, BK = 64, HALF = 128, HTB = HALF * BK * 2  , STAGE_BYTES = 8 * HTB, NXCD = 8, WGM = 8;

__host__ __device__ __forceinline__ int lds_byte(int r, int c) { const int st = (r >> 4) * 2 + (c >> 5), rr = r & 15, cc = c & 31, ob = rr * 64 + cc * 2; return st * 1024 + (ob ^ (((ob >> 9) & 1) << 5)); }
__host__ __device__ __forceinline__ void stage_rc(int b, int& R, int& C) { const int st = b / 1024, sb = b % 1024, swz = sb ^ (((sb >> 9) & 1) << 5); R = (st >> 1) * 16 + swz / 64; C = (st & 1) * 32 + (swz % 64) / 2; }
__host__ __device__ __forceinline__ int perm32(int rho) { const int n = rho >> 4, i = rho & 15; return 8 * (i >> 2) + 4 * n + (i & 3); }

struct Unit { int pm, pn; };
struct Gemm { const bf16_t* A; const bf16_t* Bt; int M, N, K; };

struct StaticOrder {
    int nM, nN, nwg, G, c;
    __host__ __device__ void init(int M, int N, int G_, int c_) { nM = M / BM; nN = N / BM; nwg = nM * nN; G = G_; c = c_; }
    __host__ __device__ bool next(int i, Unit& u) const {
        const long L = (long)i * G + c; if (L >= nwg) return false;
        int wgid = (int)L; { const int q = nwg / NXCD, r = nwg % NXCD, xcd = wgid % NXCD, off = wgid / NXCD; wgid = (xcd < r ? xcd * (q + 1) : r * (q + 1) + (xcd - r) * q) + off; }
        const int nig = WGM * nN, gid = wgid / nig, fm = gid * WGM, gsz = (nM - fm) < WGM ? (nM - fm) : WGM;
        u.pm = fm + ((wgid % nig) % gsz); u.pn = (wgid % nig) / gsz; return true;
    }
    __device__ __forceinline__ void a_ready(const Unit&) const {}
    __device__ __forceinline__ void done(const Unit&) const {}
};
__device__ __forceinline__ unsigned cvt_pk_bf16(float lo, float hi) { unsigned r; asm volatile("v_cvt_pk_bf16_f32 %0, %1, %2" : "=v"(r) : "v"(lo), "v"(hi)); return r; }
struct EpiF32 {
    static constexpr bool PERM = false, AFTER_DRAIN = false;
    float* C; int ldc;
    __device__ __forceinline__ void operator()(const f32x4 (&acc)[2][2][4][2], const Unit& u, int wr, int wc, int fr, int fq) const {
        const int row0 = u.pm * BM + wr * 64 + fr, col0 = u.pn * BM + wc * 32 + 4 * fq;
#pragma unroll
        for (int ai = 0; ai < 2; ++ai)
#pragma unroll
            for (int m = 0; m < 4; ++m) { float* rowp = C + (size_t)(row0 + ai * HALF + m * 16) * ldc + col0;
#pragma unroll
                for (int bj = 0; bj < 2; ++bj)
#pragma unroll
                    for (int n = 0; n < 2; ++n) *(f32x4*)(rowp + bj * HALF + n * 16) = acc[ai][bj][m][n]; }
    }
};
struct EpiRelu2 {
    static constexpr bool PERM = true, AFTER_DRAIN = false;
    bf16_t* O; int ldc;
    __device__ __forceinline__ void operator()(const f32x4 (&acc)[2][2][4][2], const Unit& u, int wr, int wc, int fr, int fq) const {
        const int row0 = u.pm * BM + wr * 64 + fr; const int col0 = u.pn * BM + wc * 32 + 8 * fq;
#pragma unroll
        for (int ai = 0; ai < 2; ++ai)
#pragma unroll
            for (int m = 0; m < 4; ++m) { bf16_t* rowp = O + (size_t)(row0 + ai * HALF + m * 16) * ldc + col0;
#pragma unroll
                for (int bj = 0; bj < 2; ++bj) { f32x4 v0 = acc[ai][bj][m][0], v1 = acc[ai][bj][m][1];
                    v0 = __builtin_elementwise_max(v0, (f32x4){0.f, 0.f, 0.f, 0.f}); v1 = __builtin_elementwise_max(v1, (f32x4){0.f, 0.f, 0.f, 0.f});
                    v0 = v0 * v0; v1 = v1 * v1;
                    u32x4 w; w.x = cvt_pk_bf16(v0[0], v0[1]); w.y = cvt_pk_bf16(v0[2], v0[3]); w.z = cvt_pk_bf16(v1[0], v1[1]); w.w = cvt_pk_bf16(v1[2], v1[3]);
                    *(u32x4*)(rowp + bj * HALF) = w; } }
    }
};

template <class Epi, class Sched, bool ALIGN_EPI = false, bool SP2 = false>
__device__ __forceinline__ void gemm_phase(PG8_LAS unsigned char* lds, const Gemm g, const Sched& S, const Epi& E) {
    const int tid = threadIdx.x, wid = __builtin_amdgcn_readfirstlane(tid >> 6), lane = tid & 63, wr = wid >> 2, wc = wid & 3, fr = lane & 15, fq = lane >> 4;
    const int K = g.K, nt = K / BK;
    unsigned voffA[2], voffB[2];
#pragma unroll
    for (int i = 0; i < 2; ++i) { int R, C; stage_rc(tid * 16 + i * 8192, R, C); const int Rb = Epi::PERM ? ((R & ~31) + perm32(R & 31)) : R;
        voffA[i] = (unsigned)(R * K + C) * 2u; voffB[i] = (unsigned)(Rb * K + C) * 2u; }
    const size_t kstep = (size_t)(BK * 2);
    const size_t hstep = (size_t)HALF * K * 2;
    const size_t tstep = 2 * hstep;
    const unsigned ldsw = (unsigned)wid * 1024u;
    const int aoff = lds_byte(wr * 64 + fr, fq * 8), boff = lds_byte(wc * 32 + fr, fq * 8);
#define PG8_SA(b, h) (((b) * 2 + (h)) * HTB)
#define PG8_SB(b, h) ((4 + (b) * 2 + (h)) * HTB)
#define PG8_STAGE(bufoff, gbase, voff) do { _Pragma("unroll") for (int _i = 0; _i < 2; ++_i) \
        __builtin_amdgcn_global_load_lds((const unsigned*)((const char*)(gbase) + (voff)[_i]), (PG8_LAS unsigned*)(lds + (bufoff) + ldsw + _i * 8192), 16, 0, 0); } while (0)
#define PG8_LDA(dst, b, h) do { _Pragma("unroll") for (int m = 0; m < 4; ++m) _Pragma("unroll") for (int k = 0; k < 2; ++k) dst[m][k] = *(const PG8_LAS bf16x8*)(lds + PG8_SA(b, h) + aoff + m * 2048 + k * 1024); } while (0)
#define PG8_LDB(dst, b, h) do { _Pragma("unroll") for (int n = 0; n < 2; ++n) _Pragma("unroll") for (int k = 0; k < 2; ++k) dst[n][k] = *(const PG8_LAS bf16x8*)(lds + PG8_SB(b, h) + boff + n * 2048 + k * 1024); } while (0)
#define PG8_MMA(ai, bj, At, Bt) do { __builtin_amdgcn_s_setprio(1); _Pragma("unroll") for (int m = 0; m < 4; ++m) _Pragma("unroll") for (int n = 0; n < 2; ++n) _Pragma("unroll") for (int k = 0; k < 2; ++k) \
        acc[ai][bj][m][n] = __builtin_amdgcn_mfma_f32_16x16x32_bf16(Bt[n][k], At[m][k], acc[ai][bj][m][n], 0, 0, 0); __builtin_amdgcn_s_setprio(0); } while (0)
#define PG8_WAIT_V(n) asm volatile("s_waitcnt vmcnt(" #n ")" ::: "memory")
#define PG8_WAIT_L(n) asm volatile("s_waitcnt lgkmcnt(" #n ")" ::: "memory")
#define PG8_BAR __builtin_amdgcn_s_barrier()
#define PG8_SCHED __builtin_amdgcn_sched_barrier(0)
    Unit cur, nxt; int ui = 0;
    if (!S.next(0, cur)) return;
    f32x4 acc[2][2][4][2];
#pragma unroll
    for (int a = 0; a < 2; ++a)
#pragma unroll
        for (int b = 0; b < 2; ++b)
#pragma unroll
            for (int m = 0; m < 4; ++m)
#pragma unroll
                for (int n = 0; n < 2; ++n) acc[a][b][m][n] = (f32x4){0.f, 0.f, 0.f, 0.f};
    bf16x8 At[4][2], B0[2][2], B1[2][2];
    const char* cA = (const char*)g.A + (size_t)cur.pm * tstep; const char* cB = (const char*)g.Bt + (size_t)cur.pn * tstep;
    S.a_ready(cur);
    if constexpr (SP2) {
        PG8_STAGE(PG8_SB(0, 0), cB, voffB); PG8_STAGE(PG8_SB(0, 1), cB + hstep, voffB); PG8_STAGE(PG8_SA(0, 0), cA, voffA); PG8_STAGE(PG8_SA(0, 1), cA + hstep, voffA);
        if (wr == 1) PG8_BAR;
        PG8_WAIT_V(2); PG8_BAR;
        PG8_STAGE(PG8_SB(1, 0), cB + kstep, voffB); PG8_STAGE(PG8_SA(1, 0), cA + kstep, voffA); PG8_STAGE(PG8_SB(1, 1), cB + hstep + kstep, voffB);
        PG8_WAIT_V(6); PG8_BAR;
    } else {
        PG8_STAGE(PG8_SB(0, 0), cB, voffB); PG8_STAGE(PG8_SA(0, 0), cA, voffA); PG8_STAGE(PG8_SB(0, 1), cB + hstep, voffB); PG8_STAGE(PG8_SA(0, 1), cA + hstep, voffA);
        if (wr == 1) PG8_BAR;
        PG8_WAIT_V(4); PG8_BAR;
        PG8_STAGE(PG8_SB(1, 0), cB + kstep, voffB); PG8_STAGE(PG8_SA(1, 0), cA + kstep, voffA); PG8_STAGE(PG8_SB(1, 1), cB + hstep + kstep, voffB);
        PG8_WAIT_V(6); PG8_BAR;
    }
    for (;;) {
        const bool has_next = S.next(ui + 1, nxt);
        const char* nA = has_next ? (const char*)g.A + (size_t)nxt.pm * tstep : cA; const char* nB = has_next ? (const char*)g.Bt + (size_t)nxt.pn * tstep : cB;
        for (int t = 0; t < nt; t += 2) {
            const bool last = (t == nt - 2);
            const char* a1 = cA + (size_t)(t + 1) * kstep;
            const char* a2 = last ? nA : cA + (size_t)(t + 2) * kstep; const char* b2 = last ? nB : cB + (size_t)(t + 2) * kstep;
            const char* a3 = a2 + kstep; const char* b3 = b2 + kstep;
            if (last && has_next) S.a_ready(nxt);
            if constexpr (SP2) {
            PG8_LDB(B0, 0, 0); PG8_LDB(B1, 0, 1); PG8_SCHED; PG8_LDA(At, 0, 0); PG8_STAGE(PG8_SA(1, 1), a1 + hstep, voffA);
            PG8_WAIT_V(8); PG8_WAIT_L(0); PG8_BAR; PG8_MMA(0, 0, At, B0); PG8_MMA(0, 1, At, B1); PG8_BAR; PG8_SCHED;
            PG8_LDA(At, 0, 1); PG8_STAGE(PG8_SB(0, 0), b2, voffB); PG8_STAGE(PG8_SB(0, 1), b2 + hstep, voffB); PG8_STAGE(PG8_SA(0, 0), a2, voffA);
            PG8_WAIT_V(8); PG8_WAIT_L(0); PG8_BAR; PG8_MMA(1, 0, At, B0); PG8_MMA(1, 1, At, B1); PG8_BAR; PG8_SCHED;
            PG8_LDB(B0, 1, 0); PG8_LDB(B1, 1, 1); PG8_SCHED; PG8_LDA(At, 1, 0); PG8_STAGE(PG8_SA(0, 1), a2 + hstep, voffA);
            PG8_WAIT_V(8); PG8_WAIT_L(0); PG8_BAR; PG8_MMA(0, 0, At, B0); PG8_MMA(0, 1, At, B1); PG8_BAR; PG8_SCHED;
            PG8_LDA(At, 1, 1); PG8_STAGE(PG8_SB(1, 0), b3, voffB); PG8_STAGE(PG8_SB(1, 1), b3 + hstep, voffB); PG8_STAGE(PG8_SA(1, 0), a3, voffA);
            PG8_WAIT_V(8); PG8_WAIT_L(0); PG8_BAR; PG8_MMA(1, 0, At, B0); PG8_MMA(1, 1, At, B1); PG8_BAR; PG8_SCHED;
            } else {
            PG8_LDB(B0, 0, 0); PG8_SCHED; PG8_LDA(At, 0, 0); PG8_STAGE(PG8_SA(1, 1), a1 + hstep, voffA);
            PG8_WAIT_L(8); PG8_BAR; PG8_WAIT_L(0); PG8_MMA(0, 0, At, B0); PG8_BAR; PG8_SCHED;
            PG8_LDB(B1, 0, 1); PG8_STAGE(PG8_SB(0, 0), b2, voffB);
            PG8_BAR; PG8_WAIT_L(0); PG8_MMA(0, 1, At, B1); PG8_BAR;
            PG8_LDA(At, 0, 1); PG8_STAGE(PG8_SA(0, 0), a2, voffA);
            PG8_BAR; PG8_WAIT_L(0); PG8_MMA(1, 0, At, B0); PG8_BAR; PG8_SCHED;
            PG8_STAGE(PG8_SB(0, 1), b2 + hstep, voffB);
            PG8_WAIT_V(6); PG8_BAR; PG8_MMA(1, 1, At, B1); PG8_BAR;
            PG8_LDB(B0, 1, 0); PG8_SCHED; PG8_LDA(At, 1, 0); PG8_STAGE(PG8_SA(0, 1), a2 + hstep, voffA);
            PG8_WAIT_L(8); PG8_BAR; PG8_WAIT_L(0); PG8_MMA(0, 0, At, B0); PG8_BAR; PG8_SCHED;
            PG8_LDB(B1, 1, 1); PG8_STAGE(PG8_SB(1, 0), b3, voffB);
            PG8_BAR; PG8_WAIT_L(0); PG8_MMA(0, 1, At, B1); PG8_BAR;
            PG8_LDA(At, 1, 1); PG8_STAGE(PG8_SA(1, 0), a3, voffA);
            PG8_BAR; PG8_WAIT_L(0); PG8_MMA(1, 0, At, B0); PG8_BAR; PG8_SCHED;
            PG8_STAGE(PG8_SB(1, 1), b3 + hstep, voffB);
            PG8_WAIT_V(6); PG8_BAR; PG8_MMA(1, 1, At, B1); PG8_BAR;
            }
        }
        if constexpr (ALIGN_EPI) { if (wr == 0) PG8_BAR; }
        if constexpr (!Epi::AFTER_DRAIN) { E(acc, cur, wr, wc, fr, fq); S.done(cur); }
        if (!has_next) break;
#pragma unroll
        for (int a = 0; a < 2; ++a)
#pragma unroll
            for (int b = 0; b < 2; ++b)
#pragma unroll
                for (int m = 0; m < 4; ++m)
#pragma unroll
                    for (int n = 0; n < 2; ++n) acc[a][b][m][n] = (f32x4){0.f, 0.f, 0.f, 0.f};
        cur = nxt; cA = nA; cB = nB; ++ui;
        if constexpr (ALIGN_EPI) { if (wr == 1) PG8_BAR; }
    }
    PG8_WAIT_V(0);
    if constexpr (!ALIGN_EPI) { if (wr == 0) PG8_BAR; }
    PG8_BAR;
    if constexpr (Epi::AFTER_DRAIN) { E.fused(acc, cur, wr, wc, fr, fq, lds, wid, lane); S.done(cur); }
#undef PG8_SA
#undef PG8_SB
#undef PG8_STAGE
#undef PG8_LDA
#undef PG8_LDB
#undef PG8_MMA
#undef PG8_WAIT_V
#undef PG8_WAIT_L
#undef PG8_BAR
#undef PG8_SCHED
}
}
#define GAS __attribute__((address_space(1)))
#define LAS __attribute__((address_space(3)))
typedef unsigned short bf16;
typedef unsigned v4u __attribute__((ext_vector_type(4)));
typedef float f32x4 __attribute__((ext_vector_type(4)));
typedef short bf16x8 __attribute__((ext_vector_type(8)));
typedef GAS unsigned gu32;
typedef GAS unsigned long long gu64;
#define RLX_AGENT __ATOMIC_RELAXED, __HIP_MEMORY_SCOPE_AGENT
#define LDS_WAIT() asm volatile("s_waitcnt lgkmcnt(0)" ::: "memory")
#define VM_WAIT() asm volatile("s_waitcnt vmcnt(0)" ::: "memory")
__device__ __forceinline__ unsigned long long rt() { return __builtin_amdgcn_s_memrealtime(); }
__device__ __forceinline__ unsigned f2bf(float f) { unsigned u = __builtin_bit_cast(unsigned, f); return (u + 0x7fffu + ((u >> 16) & 1u)) >> 16; }
__device__ __forceinline__ unsigned pk2(float lo, float hi) { return f2bf(lo) | (f2bf(hi) << 16); }

#define XB_TMO      128
#define XB_XCNT(j)  (256  + 64 * (j))
#define XB_XSUB(j)  (1280 + 64 * (j))
#define XB_XGEN(j)  (2304 + 64 * (j))
#define XB_TOP      3328
#define XB_TOPGEN   3392
#define XCD_BAR_WORDS 3456
#define XB_SPIN_CAP (1u << 24)

__device__ __forceinline__ unsigned xb_ld(unsigned* p)              { return __hip_atomic_load(p, __ATOMIC_RELAXED, __HIP_MEMORY_SCOPE_AGENT); }
__device__ __forceinline__ unsigned xb_add(unsigned* p, unsigned v) { return __hip_atomic_fetch_add(p, v, __ATOMIC_RELAXED, __HIP_MEMORY_SCOPE_AGENT); }
__device__ __forceinline__ unsigned xb_xcc_id() { return (unsigned)__builtin_amdgcn_s_getreg((3 << 11) | 20) & 0xFu; }
#define XB_SPIN(cond, bar) do { unsigned _sp = 0; while (cond) { __builtin_amdgcn_s_sleep(1); \
    if ((++_sp & 255u) == 0u) { if (xb_ld(&(bar)[XB_TMO])) break; if (_sp > XB_SPIN_CAP) { atomicAdd(&(bar)[XB_TMO], 1u); break; } } } } while (0)

struct XcdBarrier {
    unsigned* bar; unsigned x;
    volatile LAS unsigned* st;
};

__device__ __forceinline__ XcdBarrier xcd_barrier_post(unsigned* bar, volatile LAS unsigned* st) {
    XcdBarrier b; b.bar = bar; b.x = xb_xcc_id(); b.st = st;
    if (threadIdx.x == 0) (void)xb_add(&bar[XB_XCNT(b.x)], 1u);
    return b;
}
__device__ __forceinline__ void xcd_barrier_complete(unsigned* bar, unsigned x, unsigned& nloc, unsigned& nx) {
    const unsigned G = gridDim.x * gridDim.y * gridDim.z;
    unsigned sum, cnt, mine, sp = 0u;
    for (;;) {
        sum = 0u; cnt = 0u; mine = 0u;
#pragma unroll
        for (unsigned j = 0; j < 16; ++j) { const unsigned c = xb_ld(&bar[XB_XCNT(j)]); sum += c; cnt += (c > 0u) ? 1u : 0u; mine = (j == x) ? c : mine; }
        if (sum == G) break;
        __builtin_amdgcn_s_sleep(1);
        if ((++sp & 255u) == 0u) { if (xb_ld(&bar[XB_TMO])) break; if (sp > XB_SPIN_CAP) { atomicAdd(&bar[XB_TMO], 1u); break; } }
    }
    nloc = mine > 0u ? mine : 1u; nx = cnt > 0u ? cnt : 1u;
}

__device__ __forceinline__ void xcd_barrier(const XcdBarrier& b) {
    asm volatile("s_waitcnt vmcnt(0)" ::: "memory");
    __syncthreads();
    if (threadIdx.x == 0) {
        unsigned* bar = b.bar;
        __builtin_amdgcn_s_waitcnt(0);
        unsigned nloc = b.st[0], nx = b.st[1];
        if (nloc == 0u) { xcd_barrier_complete(bar, b.x, nloc, nx); b.st[0] = nloc; b.st[1] = nx; }
        const unsigned old = xb_add(&bar[XB_XSUB(b.x)], 1u);
        const unsigned gen = old / nloc;
        if (old + 1u == (gen + 1u) * nloc) {
            __builtin_amdgcn_fence(__ATOMIC_RELEASE, "agent");
            asm volatile("s_waitcnt vmcnt(0)" ::: "memory");
            const unsigned og = xb_add(&bar[XB_TOP], 1u);
            const unsigned tg = og / nx;
            if (og + 1u == (tg + 1u) * nx) xb_add(&bar[XB_TOPGEN], 1u);
            else XB_SPIN(xb_ld(&bar[XB_TOPGEN]) == tg, bar);
            __builtin_amdgcn_fence(__ATOMIC_ACQUIRE, "agent");
            xb_add(&bar[XB_XGEN(b.x)], 1u);
            asm volatile("s_waitcnt vmcnt(0)" ::: "memory");
        } else {
            XB_SPIN(xb_ld(&bar[XB_XGEN(b.x)]) == gen, bar);
            __builtin_amdgcn_fence(__ATOMIC_ACQUIRE, "agent");
            asm volatile("s_waitcnt vmcnt(0)" ::: "memory");
        }
    }
    __syncthreads();
}
constexpr int S = 8192, D = 2048, FF = 8192;
constexpr int A_H = 32, A_HD = 64, A_KV = 4, A_NQKV = 2560, A_WIN = 128;
constexpr int B_H = 16, B_HD = 128, B_KV = 4, B_NQKV = 3072, MB = 256, NBLK = S / MB;
constexpr float ALPHA = 1.4142135623730951f, LN_EPS = 1e-5f, LOG2E = 1.4426950408889634f;
constexpr float QS_A = 0.125f * LOG2E;
constexpr float QS_B = 0.08838834764831845f * LOG2E;
constexpr int NWAVES = 8, NTHR = 512;

constexpr size_t MiB = 1u << 20;
constexpr size_t WS_CTL = 0, CTL_ZERO_BYTES = 1 * MiB;
constexpr size_t WS_COSA = 1 * MiB, WS_SINA = 2 * MiB, WS_COSB = 3 * MiB, WS_SINB = 5 * MiB, WS_KBAR = 7 * MiB;
constexpr size_t WS_WQKV = 8 * MiB, WS_WO = 18 * MiB, WS_W1 = 26 * MiB  , WS_W2 = 90 * MiB  , WS_WQKVB = 154 * MiB, WS_WOB = 166 * MiB;
constexpr size_t WS_XB = 174 * MiB;
constexpr size_t WS_R = 206 * MiB;
constexpr size_t WS_Q = WS_R + 96 * MiB;
constexpr size_t WS_O = 334 * MiB;
constexpr size_t WS_K = 366 * MiB, WS_V = 370 * MiB;
constexpr size_t WS_KB = 374 * MiB, WS_VB = 382 * MiB;
constexpr size_t WS_C = 390 * MiB;
constexpr size_t WS_END = 486 * MiB;
constexpr int CW_TMO = 0, CW_BAR = 4096;

constexpr int RING_OFF = 0, RING_BYTES = 131072;
constexpr int LDSCTL_OFF = RING_BYTES, MISC_OFF = LDSCTL_OFF + 320;
constexpr int LDS_BYTES = 147456;

__device__ __forceinline__ float wave_sum(float v) {
#pragma unroll
    for (int o = 1; o < 64; o <<= 1) v += __shfl_xor(v, o);
    return v;
}
__device__ __forceinline__ void p0_transpose_item(const float* W, int K, int N, bf16* WT, int row_off, LAS float* scr, int item, int lane) {
    const int nblk = N / 32, kb = item / nblk, nb = item % nblk, k0 = 64 * kb, n0 = 32 * nb;
#pragma unroll 8
    for (int i = 0; i < 32; ++i) { const int kk = 2 * i + (lane >> 5); scr[kk * 33 + (lane & 31)] = W[(size_t)(k0 + kk) * N + n0 + (lane & 31)]; }
    LDS_WAIT(); asm volatile("" ::: "memory");
    const int c = lane & 7;
#pragma unroll
    for (int j = 0; j < 4; ++j) { const int n = (lane >> 3) + 8 * j; const LAS float* s = scr + (8 * c) * 33 + n;
        v4u o; o.x = pk2(s[0 * 33], s[1 * 33]); o.y = pk2(s[2 * 33], s[3 * 33]); o.z = pk2(s[4 * 33], s[5 * 33]); o.w = pk2(s[6 * 33], s[7 * 33]);
        *(GAS v4u*)(WT + (size_t)(row_off + n0 + n) * K + k0 + 8 * c) = o; }
    LDS_WAIT(); asm volatile("" ::: "memory");
}
struct Ctx { LAS unsigned char* lds; int tid, lane, wave, vcu, G; };

__device__ __forceinline__ void p0_prologue(const Ctx& c, const float* const* in, unsigned char* ws) {
    LAS float* scr = (LAS float*)(c.lds + RING_OFF + c.wave * 16384);
    const int gw = c.vcu * NWAVES + c.wave, NGW = c.G * NWAVES;
    constexpr int I_QKV = (D / 64) * (A_NQKV / 32), I_SQ = (D / 64) * (D / 32), I_KV = (D / 64) * (1024 / 32), I_W1 = (D / 64) * (FF / 32), I_W2 = (FF / 64) * (D / 32);
    constexpr int NITEMS = I_QKV + 3 * I_SQ + I_KV + 2 * I_W1 + 2 * I_W2;
    for (int it = gw; it < NITEMS; it += NGW) {
        int r = it;
        if (r < I_QKV) { p0_transpose_item(in[2], D, A_NQKV, (bf16*)(ws + WS_WQKV), 0, scr, r, c.lane); continue; } r -= I_QKV;
        if (r < I_SQ) { p0_transpose_item(in[5], D, D, (bf16*)(ws + WS_WO), 0, scr, r, c.lane); continue; } r -= I_SQ;
        if (r < I_SQ) { p0_transpose_item(in[6], D, D, (bf16*)(ws + WS_WQKVB), 0, scr, r, c.lane); continue; } r -= I_SQ;
        if (r < I_KV) { p0_transpose_item(in[8], D, 1024, (bf16*)(ws + WS_WQKVB), D, scr, r, c.lane); continue; } r -= I_KV;
        if (r < I_SQ) { p0_transpose_item(in[7], D, D, (bf16*)(ws + WS_WOB), 0, scr, r, c.lane); continue; } r -= I_SQ;
        if (r < I_W1) { p0_transpose_item(in[13], D, FF, (bf16*)(ws + WS_W1), 0, scr, r, c.lane); continue; } r -= I_W1;
        if (r < I_W1) { p0_transpose_item(in[13] + (size_t)D * FF, D, FF, (bf16*)(ws + WS_W1 + 32 * MiB), 0, scr, r, c.lane); continue; } r -= I_W1;
        if (r < I_W2) { p0_transpose_item(in[14], FF, D, (bf16*)(ws + WS_W2), 0, scr, r, c.lane); continue; } r -= I_W2;
        p0_transpose_item(in[14] + (size_t)D * FF, FF, D, (bf16*)(ws + WS_W2 + 32 * MiB), 0, scr, r, c.lane);
    }
    const int gt = c.vcu * NTHR + c.tid, NGT = c.G * NTHR;
    { const f32x4* x4 = (const f32x4*)in[0]; v4u* o = (v4u*)(ws + WS_XB);
      for (int i = gt; i < S * D / 8; i += NGT) { const f32x4 a = x4[2 * i], b = x4[2 * i + 1]; v4u w; w.x = pk2(a[0], a[1]); w.y = pk2(a[2], a[3]); w.z = pk2(b[0], b[1]); w.w = pk2(b[2], b[3]); o[i] = w; } }
    { const int* pos = (const int*)in[1]; float* cA = (float*)(ws + WS_COSA); float* sA = (float*)(ws + WS_SINA); float* cB = (float*)(ws + WS_COSB); float* sB = (float*)(ws + WS_SINB);
      for (int i = gt; i < S * 96; i += NGT) { const int s = i / 96, j = i % 96; const bool isA = j < 32; const int fi = isA ? j : j - 32; const double dd = isA ? 64.0 : 128.0;
          const double invf = exp2(-(double)(2 * fi) / dd * 13.287712379549449); const double ang = (double)pos[s] * invf;
          double t = ang * 0.15915494309189535; t -= rint(t); const double r = t * 6.283185307179586;
          const float cv = (float)cos(r), sv = (float)sin(r);
          if (isA) { cA[s * 32 + fi] = cv; sA[s * 32 + fi] = sv; } else { cB[s * 64 + fi] = cv; sB[s * 64 + fi] = sv; } } }
}

__device__ __forceinline__ void p_rope_a(const Ctx& c, const float* C, const float* bias, unsigned char* ws) {
    const int gt = c.vcu * NTHR + c.tid, NGT = c.G * NTHR;
    const float* cA = (const float*)(ws + WS_COSA); const float* sA = (const float*)(ws + WS_SINA);
    bf16* Q = (bf16*)(ws + WS_Q); bf16* K = (bf16*)(ws + WS_K); bf16* V = (bf16*)(ws + WS_V);
    for (int idx = gt; idx < S * 1280; idx += NGT) {
        const int s = idx / 1280, p = idx % 1280; const float* Cr = C + (size_t)s * A_NQKV;
        if (p < 1152) { const int h = p >> 5, d = p & 31; const int c0 = h * 64 + d;
            const float x1 = Cr[c0] + bias[c0], x2 = Cr[c0 + 32] + bias[c0 + 32]; const float cs = cA[s * 32 + d], sn = sA[s * 32 + d];
            float o1 = x1 * cs - x2 * sn, o2 = x2 * cs + x1 * sn;
            if (h < 32) { o1 *= QS_A; o2 *= QS_A; Q[(size_t)s * 2048 + c0] = (bf16)f2bf(o1); Q[(size_t)s * 2048 + c0 + 32] = (bf16)f2bf(o2); }
            else { const int kc = (h - 32) * 64 + d; K[(size_t)s * 256 + kc] = (bf16)f2bf(o1); K[(size_t)s * 256 + kc + 32] = (bf16)f2bf(o2); }
        } else { const int v0 = (p - 1152) * 2; const int c0 = 2304 + v0;
            *(unsigned*)(V + (size_t)s * 256 + v0) = pk2(Cr[c0] + bias[c0], Cr[c0 + 1] + bias[c0 + 1]); }
    }
}
__device__ __forceinline__ void p_rope_b(const Ctx& c, const float* C, unsigned char* ws) {
    const int gt = c.vcu * NTHR + c.tid, NGT = c.G * NTHR;
    const float* cB = (const float*)(ws + WS_COSB); const float* sB = (const float*)(ws + WS_SINB);
    bf16* Q = (bf16*)(ws + WS_Q); bf16* K = (bf16*)(ws + WS_KB); bf16* V = (bf16*)(ws + WS_VB);
    for (int idx = gt; idx < S * 1536; idx += NGT) {
        const int s = idx / 1536, p = idx % 1536; const float* Cr = C + (size_t)s * B_NQKV;
        if (p < 1280) { const int h = p >> 6, d = p & 63; const int c0 = h * 128 + d;
            const float x1 = Cr[c0], x2 = Cr[c0 + 64]; const float cs = cB[s * 64 + d], sn = sB[s * 64 + d];
            float o1 = x1 * cs - x2 * sn, o2 = x2 * cs + x1 * sn;
            if (h < 16) { o1 *= QS_B; o2 *= QS_B; Q[(size_t)s * 2048 + c0] = (bf16)f2bf(o1); Q[(size_t)s * 2048 + c0 + 64] = (bf16)f2bf(o2); }
            else { const int kc = (h - 16) * 128 + d; K[(size_t)s * 512 + kc] = (bf16)f2bf(o1); K[(size_t)s * 512 + kc + 64] = (bf16)f2bf(o2); }
        } else { const int v0 = (p - 1280) * 2; const int c0 = 2560 + v0;
            *(unsigned*)(V + (size_t)s * 512 + v0) = pk2(Cr[c0], Cr[c0 + 1]); }
    }
}
__device__ __forceinline__ float bf2f(unsigned short b) { return __builtin_bit_cast(float, (unsigned)b << 16); }
__device__ __forceinline__ void unpack8(const v4u w, float* f) {
    f[0] = __builtin_bit_cast(float, w.x << 16); f[1] = __builtin_bit_cast(float, w.x & 0xffff0000u);
    f[2] = __builtin_bit_cast(float, w.y << 16); f[3] = __builtin_bit_cast(float, w.y & 0xffff0000u);
    f[4] = __builtin_bit_cast(float, w.z << 16); f[5] = __builtin_bit_cast(float, w.z & 0xffff0000u);
    f[6] = __builtin_bit_cast(float, w.w << 16); f[7] = __builtin_bit_cast(float, w.w & 0xffff0000u);
}
__device__ __forceinline__ void p_swa_naive(const Ctx& c, const float* sinks, unsigned char* ws) {
    const int gt = c.vcu * NTHR + c.tid, NGT = c.G * NTHR;
    const bf16* Q = (const bf16*)(ws + WS_Q); const bf16* K = (const bf16*)(ws + WS_K); const bf16* V = (const bf16*)(ws + WS_V); bf16* O = (bf16*)(ws + WS_O);
    for (int idx = gt; idx < S * A_H; idx += NGT) {
        const int s = idx >> 5, h = idx & 31, kvh = h >> 3;
        float q[64];
#pragma unroll
        for (int i = 0; i < 8; ++i) unpack8(*(const v4u*)(Q + (size_t)s * 2048 + h * 64 + 8 * i), q + 8 * i);
        float m = sinks[h] * LOG2E, l = 1.f; float o[64];
#pragma unroll
        for (int i = 0; i < 64; ++i) o[i] = 0.f;
        const int j0 = s - (A_WIN - 1) < 0 ? 0 : s - (A_WIN - 1);
        for (int j = j0; j <= s; ++j) {
            float sc = 0.f;
#pragma unroll
            for (int i = 0; i < 8; ++i) { float kf[8]; unpack8(*(const v4u*)(K + (size_t)j * 256 + kvh * 64 + 8 * i), kf);
#pragma unroll
                for (int e = 0; e < 8; ++e) sc += q[8 * i + e] * kf[e]; }
            const float mn = fmaxf(m, sc), corr = exp2f(m - mn), p = exp2f(sc - mn); m = mn; l = l * corr + p;
#pragma unroll
            for (int i = 0; i < 8; ++i) { float vf[8]; unpack8(*(const v4u*)(V + (size_t)j * 256 + kvh * 64 + 8 * i), vf);
#pragma unroll
                for (int e = 0; e < 8; ++e) o[8 * i + e] = o[8 * i + e] * corr + p * vf[e]; }
        }
        const float rl = 1.f / l;
#pragma unroll
        for (int i = 0; i < 8; ++i) { v4u w; w.x = pk2(o[8 * i] * rl, o[8 * i + 1] * rl); w.y = pk2(o[8 * i + 2] * rl, o[8 * i + 3] * rl); w.z = pk2(o[8 * i + 4] * rl, o[8 * i + 5] * rl); w.w = pk2(o[8 * i + 6] * rl, o[8 * i + 7] * rl);
            *(v4u*)(O + (size_t)s * 2048 + h * 64 + 8 * i) = w; }
    }
}
__device__ __forceinline__ void p_kbar(const Ctx& c, unsigned char* ws) {
    const int gt = c.vcu * NTHR + c.tid, NGT = c.G * NTHR;
    const bf16* K = (const bf16*)(ws + WS_KB); float* kbar = (float*)(ws + WS_KBAR);
    for (int idx = gt; idx < B_KV * NBLK * B_HD; idx += NGT) { const int d = idx & 127, n = (idx >> 7) & 31, kvh = idx >> 12; float a = 0.f;
        for (int r = 0; r < MB; ++r) a += bf2f(K[(size_t)(n * MB + r) * 512 + kvh * 128 + d]);
        kbar[idx] = a * (1.f / MB); }
}
__device__ __forceinline__ float wave_max(float v) {
#pragma unroll
    for (int o = 1; o < 64; o <<= 1) v = fmaxf(v, __shfl_xor(v, o));
    return v;
}
__device__ __forceinline__ void p_moba_naive(const Ctx& c, unsigned char* ws) {
    const int gw = c.vcu * NWAVES + c.wave, NGW = c.G * NWAVES, lane = c.lane;
    const bf16* Q = (const bf16*)(ws + WS_Q); const bf16* K = (const bf16*)(ws + WS_KB); const bf16* V = (const bf16*)(ws + WS_VB); bf16* O = (bf16*)(ws + WS_O);
    const float* kbar = (const float*)(ws + WS_KBAR);
    LAS float* qs = (LAS float*)(c.lds + c.wave * 8192); LAS float* ps = qs + 128;
    for (int task = gw; task < S * B_H; task += NGW) {
        const int s = task >> 4, h = task & 15, kvh = h >> 2, qb = s >> 8;
        { const unsigned w = *(const unsigned*)(Q + (size_t)s * 2048 + h * 128 + 2 * lane); qs[2 * lane] = __builtin_bit_cast(float, w << 16); qs[2 * lane + 1] = __builtin_bit_cast(float, w & 0xffff0000u); }
        LDS_WAIT(); asm volatile("" ::: "memory");
        float g = -INFINITY;
        if (lane < qb) { const float* kb = kbar + (size_t)(kvh * NBLK + lane) * 128; float a = 0.f; for (int d = 0; d < 128; ++d) a += qs[d] * kb[d]; g = a; }
        int sel[4];
#pragma unroll
        for (int r = 0; r < 3; ++r) { float bv = g; int bi = lane;
#pragma unroll
            for (int o = 1; o < 64; o <<= 1) { const float ov = __shfl_xor(bv, o); const int oi = __shfl_xor(bi, o); if (ov > bv || (ov == bv && oi < bi)) { bv = ov; bi = oi; } }
            sel[r] = (bv == -INFINITY) ? -1 : bi; if (lane == bi) g = -INFINITY; }
        sel[3] = qb;
        float sc[4][4]; float mx = -INFINITY;
#pragma unroll
        for (int b = 0; b < 4; ++b) {
#pragma unroll
            for (int t = 0; t < 4; ++t) { sc[b][t] = -INFINITY;
                if (sel[b] >= 0) { const int j = sel[b] * MB + lane + 64 * t; const bf16* kr = K + (size_t)j * 512 + kvh * 128; float a = 0.f;
                    for (int i = 0; i < 16; ++i) { float kf[8]; unpack8(*(const v4u*)(kr + 8 * i), kf);
#pragma unroll
                        for (int e = 0; e < 8; ++e) a += qs[8 * i + e] * kf[e]; }
                    if (b == 3 && j > s) a = -INFINITY; sc[b][t] = a; mx = fmaxf(mx, a); } } }
        mx = wave_max(mx); float ls = 0.f;
#pragma unroll
        for (int b = 0; b < 4; ++b)
#pragma unroll
            for (int t = 0; t < 4; ++t) { const float p = exp2f(sc[b][t] - mx); ls += p; ps[b * 256 + lane + 64 * t] = p; }
        ls = wave_sum(ls);
        LDS_WAIT(); asm volatile("" ::: "memory");
        float o0 = 0.f, o1 = 0.f;
#pragma unroll
        for (int b = 0; b < 4; ++b) { if (sel[b] < 0) continue; const bf16* vr = V + (size_t)(sel[b] * MB) * 512 + kvh * 128 + 2 * lane;
            for (int jj = 0; jj < MB; ++jj) { const float p = ps[b * 256 + jj]; const unsigned w = *(const unsigned*)(vr + (size_t)jj * 512);
                o0 += p * __builtin_bit_cast(float, w << 16); o1 += p * __builtin_bit_cast(float, w & 0xffff0000u); } }
        const float rl = 1.f / ls;
        *(unsigned*)(O + (size_t)s * 2048 + h * 128 + 2 * lane) = pk2(o0 * rl, o1 * rl);
        LDS_WAIT(); asm volatile("" ::: "memory");
    }
}
__device__ __forceinline__ void p_ln(const Ctx& c, const float* res, const float* C, const float* g, const float* b, float* out, bf16* xb) {
    const int gw = c.vcu * NWAVES + c.wave, NGW = c.G * NWAVES, lane = c.lane;
    for (int row = gw; row < S; row += NGW) {
        const f32x4* r4 = (const f32x4*)(res + (size_t)row * D) + lane; const f32x4* c4 = (const f32x4*)(C + (size_t)row * D) + lane;
        f32x4 v[8]; float sm = 0.f;
#pragma unroll
        for (int j = 0; j < 8; ++j) { v[j] = r4[64 * j] * ALPHA + c4[64 * j]; sm += (v[j][0] + v[j][1]) + (v[j][2] + v[j][3]); }
        const float mean = wave_sum(sm) * (1.f / D); float s2 = 0.f;
#pragma unroll
        for (int j = 0; j < 8; ++j) { v[j] = v[j] - mean; s2 += (v[j][0] * v[j][0] + v[j][1] * v[j][1]) + (v[j][2] * v[j][2] + v[j][3] * v[j][3]); }
        const float rstd = 1.f / sqrtf(wave_sum(s2) * (1.f / D) + LN_EPS);
        f32x4* o4 = (f32x4*)(out + (size_t)row * D) + lane; unsigned long long* o8 = (unsigned long long*)(xb + (size_t)row * D) + lane;
#pragma unroll
        for (int j = 0; j < 8; ++j) { const f32x4 gg = ((const f32x4*)g)[lane + 64 * j], bb = ((const f32x4*)b)[lane + 64 * j]; const f32x4 y = v[j] * rstd * gg + bb;
            o4[64 * j] = y; o8[64 * j] = (unsigned long long)pk2(y[0], y[1]) | ((unsigned long long)pk2(y[2], y[3]) << 32); }
    }
}

struct Args { const float* in[15]; float* out; unsigned char* ws; int ph_lo, ph_hi, li, pad; };
constexpr int N_PHASES = 18;
#ifndef MK_N_LAUNCHES
#define MK_N_LAUNCHES 1
#endif
__global__ void __launch_bounds__(NTHR, 2) fwd(Args args) {
    extern __shared__ __attribute__((aligned(16))) unsigned char lds[];
    Ctx c; c.lds = (LAS unsigned char*)lds; c.tid = threadIdx.x; c.lane = c.tid & 63; c.wave = __builtin_amdgcn_readfirstlane(c.tid >> 6);
    c.G = gridDim.x; { const int bx = blockIdx.x; c.vcu = (c.G % 8 == 0) ? (bx % 8) * (c.G / 8) + bx / 8 : bx; }
    volatile LAS unsigned* MISC = (volatile LAS unsigned*)(c.lds + MISC_OFF);
    unsigned char* ws = args.ws; gu32* ctl = (gu32*)(ws + WS_CTL);
    for (int u = c.tid; u < (LDS_BYTES - LDSCTL_OFF) / 4; u += NTHR) ((LAS unsigned*)(c.lds + LDSCTL_OFF))[u] = 0u;
    __syncthreads();
    XcdBarrier bar; bar.bar = (unsigned*)(ctl + CW_BAR) + args.li * XCD_BAR_WORDS; bar.x = 0; bar.st = nullptr;
    if (MK_N_LAUNCHES == 1) bar = xcd_barrier_post((unsigned*)(ctl + CW_BAR), MISC + 8);
    const int lo = args.ph_lo, hi = args.ph_hi;
#define IN(k) (lo <= (k) && (k) < hi)
#define SEAM(k) do { if (IN(k) && IN((k) + 1)) xcd_barrier(bar); } while (0)
    const float* const* in = args.in; float* out = args.out;
    float* C = (float*)(ws + WS_C); bf16* XB = (bf16*)(ws + WS_XB); bf16* HID = (bf16*)(ws + WS_R); bf16* OB = (bf16*)(ws + WS_O);
    typedef pg8::bf16_t pb;
#define GEMM_F32(Aptr, Bptr, Nn, Kk) do { pg8::Gemm g{(const pb*)(Aptr), (const pb*)(Bptr), S, (Nn), (Kk)}; pg8::StaticOrder So; So.init(S, (Nn), c.G, (int)blockIdx.x); pg8::EpiF32 E{C, (Nn)}; \
        pg8::gemm_phase<pg8::EpiF32, pg8::StaticOrder, true, true>(c.lds + RING_OFF, g, So, E); } while (0)
#define GEMM_RELU2(Aptr, Bptr, Nn, Kk) do { pg8::Gemm g{(const pb*)(Aptr), (const pb*)(Bptr), S, (Nn), (Kk)}; pg8::StaticOrder So; So.init(S, (Nn), c.G, (int)blockIdx.x); pg8::EpiRelu2 E{(pb*)HID, (Nn)}; \
        pg8::gemm_phase<pg8::EpiRelu2, pg8::StaticOrder, true, true>(c.lds + RING_OFF, g, So, E); } while (0)

    if (IN(0)) p0_prologue(c, in, ws);
    SEAM(0);
    if (IN(1)) GEMM_F32(XB, ws + WS_WQKV, A_NQKV, D);
    SEAM(1);
    if (IN(2)) p_rope_a(c, C, in[3], ws);
    SEAM(2);
    if (IN(3)) p_swa_naive(c, in[4], ws);
    SEAM(3);
    if (IN(4)) GEMM_F32(OB, ws + WS_WO, D, D);
    SEAM(4);
    if (IN(5)) p_ln(c, in[0], C, in[9], in[10], out, XB);
    SEAM(5);
    if (IN(6)) GEMM_RELU2(XB, ws + WS_W1, FF, D);
    SEAM(6);
    if (IN(7)) GEMM_F32(HID, ws + WS_W2, D, FF);
    SEAM(7);
    if (IN(8)) p_ln(c, out, C, in[11], in[12], out, XB);
    SEAM(8);
    if (IN(9)) GEMM_F32(XB, ws + WS_WQKVB, B_NQKV, D);
    SEAM(9);
    if (IN(10)) p_rope_b(c, C, ws);
    SEAM(10);
    if (IN(11)) p_kbar(c, ws);
    SEAM(11);
    if (IN(12)) p_moba_naive(c, ws);
    SEAM(12);
    if (IN(13)) GEMM_F32(OB, ws + WS_WOB, D, D);
    SEAM(13);
    if (IN(14)) p_ln(c, out, C, in[9] + D, in[10] + D, out, XB);
    SEAM(14);
    if (IN(15)) GEMM_RELU2(XB, ws + WS_W1 + 32 * MiB, FF, D);
    SEAM(15);
    if (IN(16)) GEMM_F32(HID, ws + WS_W2 + 32 * MiB, D, FF);
    SEAM(16);
    if (IN(17)) p_ln(c, out, C, in[11] + D, in[12] + D, out, XB);
#undef IN
#undef SEAM
}

extern "C" void kernel_launch(void* const* d_in, const int* in_sizes, int n_in, void* d_out, int out_size, void* d_ws, size_t ws_size, hipStream_t stream) {
    static int grid = 0;
    if (grid == 0) {
        if (n_in != 15 || out_size != S * D || ws_size < WS_END) { fprintf(stderr, "kernel_launch: unexpected sizes n_in %d out %d ws %zu\n", n_in, out_size, ws_size); grid = -1; return; }
        int dev = 0, cus = 0, per_cu = 0;
        if (hipGetDevice(&dev) != hipSuccess || hipDeviceGetAttribute(&cus, hipDeviceAttributeMultiprocessorCount, dev) != hipSuccess) { grid = -1; return; }
        if (hipFuncSetAttribute((const void*)fwd, hipFuncAttributeMaxDynamicSharedMemorySize, LDS_BYTES) != hipSuccess) { fprintf(stderr, "kernel_launch: hipFuncSetAttribute failed\n"); grid = -1; return; }
        if (hipOccupancyMaxActiveBlocksPerMultiprocessor(&per_cu, (const void*)fwd, NTHR, LDS_BYTES) != hipSuccess || per_cu < 1) { fprintf(stderr, "kernel_launch: occupancy query says %d\n", per_cu); }
        (void)hipGetLastError();
        grid = cus;
    }
    if (grid < 0) return;
    (void)hipMemsetAsync((char*)d_ws + WS_CTL, 0, CTL_ZERO_BYTES, stream);
    Args a{};
    for (int i = 0; i < 15; ++i) a.in[i] = (const float*)d_in[i];
    a.out = (float*)d_out; a.ws = (unsigned char*)d_ws;
    if (MK_N_LAUNCHES == 1) { a.ph_lo = 0; a.ph_hi = N_PHASES; a.li = 0; hipLaunchKernelGGL(fwd, dim3(grid), dim3(NTHR), LDS_BYTES, stream, a); }
    else { for (int p = 0; p < N_PHASES; ++p) { a.ph_lo = p; a.ph_hi = p + 1; a.li = 0; hipLaunchKernelGGL(fwd, dim3(grid), dim3(NTHR), LDS_BYTES, stream, a); } }
}
```

```cpp
#include <hip/hip_runtime.h>
#include <cstdio>
#include <cstdint>
namespace pg8 {
#define PG8_LAS __attribute__((address_space(3)))
typedef unsigned short bf16_t;
typedef short bf16x8 __attribute__((ext_vector_type(8)));
typedef float f32x4 __attribute__((ext_vector_type(4)));
typedef unsigned u32x4 __attribute__((ext_vector_type(4)));
constexpr int BM = 256, BK = 64, HALF = 128, HTB = HALF * BK * 2  , STAGE_BYTES = 8 * HTB, NXCD = 8, WGM = 8;

__host__ __device__ __forceinline__ int lds_byte(int r, int c) { const int st = (r >> 4) * 2 + (c >> 5), rr = r & 15, cc = c & 31, ob = rr * 64 + cc * 2; return st * 1024 + (ob ^ (((ob >> 9) & 1) << 5)); }
__host__ __device__ __forceinline__ void stage_rc(int b, int& R, int& C) { const int st = b / 1024, sb = b % 1024, swz = sb ^ (((sb >> 9) & 1) << 5); R = (st >> 1) * 16 + swz / 64; C = (st & 1) * 32 + (swz % 64) / 2; }
__host__ __device__ __forceinline__ int perm32(int rho) { const int n = rho >> 4, i = rho & 15; return 8 * (i >> 2) + 4 * n + (i & 3); }

struct Unit { int pm, pn; };
struct Gemm { const bf16_t* A; const bf16_t* Bt; int M, N, K; };

struct StaticOrder {
    int nM, nN, nwg, G, c;
    __host__ __device__ void init(int M, int N, int G_, int c_) { nM = M / BM; nN = N / BM; nwg = nM * nN; G = G_; c = c_; }
    __host__ __device__ bool next(int i, Unit& u) const {
        const long L = (long)i * G + c; if (L >= nwg) return false;
        int wgid = (int)L; { const int q = nwg / NXCD, r = nwg % NXCD, xcd = wgid % NXCD, off = wgid / NXCD; wgid = (xcd < r ? xcd * (q + 1) : r * (q + 1) + (xcd - r) * q) + off; }
        const int nig = WGM * nN, gid = wgid / nig, fm = gid * WGM, gsz = (nM - fm) < WGM ? (nM - fm) : WGM;
        u.pm = fm + ((wgid % nig) % gsz); u.pn = (wgid % nig) / gsz; return true;
    }
    __device__ __forceinline__ void a_ready(const Unit&) const {}
    __device__ __forceinline__ void done(const Unit&) const {}
};
__device__ __forceinline__ unsigned cvt_pk_bf16(float lo, float hi) { unsigned r; asm volatile("v_cvt_pk_bf16_f32 %0, %1, %2" : "=v"(r) : "v"(lo), "v"(hi)); return r; }
struct EpiF32 {
    static constexpr bool PERM = false, AFTER_DRAIN = false;
    float* C; int ldc;
    __device__ __forceinline__ void operator()(const f32x4 (&acc)[2][2][4][2], const Unit& u, int wr, int wc, int fr, int fq) const {
        const int row0 = u.pm * BM + wr * 64 + fr, col0 = u.pn * BM + wc * 32 + 4 * fq;
#pragma unroll
        for (int ai = 0; ai < 2; ++ai)
#pragma unroll
            for (int m = 0; m < 4; ++m) { float* rowp = C + (size_t)(row0 + ai * HALF + m * 16) * ldc + col0;
#pragma unroll
                for (int bj = 0; bj < 2; ++bj)
#pragma unroll
                    for (int n = 0; n < 2; ++n) *(f32x4*)(rowp + bj * HALF + n * 16) = acc[ai][bj][m][n]; }
    }
};
struct EpiRelu2 {
    static constexpr bool PERM = true, AFTER_DRAIN = false;
    bf16_t* O; int ldc;
    __device__ __forceinline__ void operator()(const f32x4 (&acc)[2][2][4][2], const Unit& u, int wr, int wc, int fr, int fq) const {
        const int row0 = u.pm * BM + wr * 64 + fr; const int col0 = u.pn * BM + wc * 32 + 8 * fq;
#pragma unroll
        for (int ai = 0; ai < 2; ++ai)
#pragma unroll
            for (int m = 0; m < 4; ++m) { bf16_t* rowp = O + (size_t)(row0 + ai * HALF + m * 16) * ldc + col0;
#pragma unroll
                for (int bj = 0; bj < 2; ++bj) { f32x4 v0 = acc[ai][bj][m][0], v1 = acc[ai][bj][m][1];
                    v0 = __builtin_elementwise_max(v0, (f32x4){0.f, 0.f, 0.f, 0.f}); v1 = __builtin_elementwise_max(v1, (f32x4){0.f, 0.f, 0.f, 0.f});
                    v0 = v0 * v0; v1 = v1 * v1;
                    u32x4 w; w.x = cvt_pk_bf16(v0[0], v0[1]); w.y = cvt_pk_bf16(v0[2], v0[3]); w.z = cvt_pk_bf16(v1[0], v1[1]); w.w = cvt_pk_bf16(v1[2], v1[3]);
                    *(u32x4*)(rowp + bj * HALF) = w; } }
    }
};

template <class Epi, class Sched, bool ALIGN_EPI = false, bool SP2 = false>
__device__ __forceinline__ void gemm_phase(PG8_LAS unsigned char* lds, const Gemm g, const Sched& S, const Epi& E) {
    const int tid = threadIdx.x, wid = __builtin_amdgcn_readfirstlane(tid >> 6), lane = tid & 63, wr = wid >> 2, wc = wid & 3, fr = lane & 15, fq = lane >> 4;
    const int K = g.K, nt = K / BK;
    unsigned voffA[2], voffB[2];
#pragma unroll
    for (int i = 0; i < 2; ++i) { int R, C; stage_rc(tid * 16 + i * 8192, R, C); const int Rb = Epi::PERM ? ((R & ~31) + perm32(R & 31)) : R;
        voffA[i] = (unsigned)(R * K + C) * 2u; voffB[i] = (unsigned)(Rb * K + C) * 2u; }
    const size_t kstep = (size_t)(BK * 2);
    const size_t hstep = (size_t)HALF * K * 2;
    const size_t tstep = 2 * hstep;
    const unsigned ldsw = (unsigned)wid * 1024u;
    const int aoff = lds_byte(wr * 64 + fr, fq * 8), boff = lds_byte(wc * 32 + fr, fq * 8);
#define PG8_SA(b, h) (((b) * 2 + (h)) * HTB)
#define PG8_SB(b, h) ((4 + (b) * 2 + (h)) * HTB)
#define PG8_STAGE(bufoff, gbase, voff) do { _Pragma("unroll") for (int _i = 0; _i < 2; ++_i) \
        __builtin_amdgcn_global_load_lds((const unsigned*)((const char*)(gbase) + (voff)[_i]), (PG8_LAS unsigned*)(lds + (bufoff) + ldsw + _i * 8192), 16, 0, 0); } while (0)
#define PG8_LDA(dst, b, h) do { _Pragma("unroll") for (int m = 0; m < 4; ++m) _Pragma("unroll") for (int k = 0; k < 2; ++k) dst[m][k] = *(const PG8_LAS bf16x8*)(lds + PG8_SA(b, h) + aoff + m * 2048 + k * 1024); } while (0)
#define PG8_LDB(dst, b, h) do { _Pragma("unroll") for (int n = 0; n < 2; ++n) _Pragma("unroll") for (int k = 0; k < 2; ++k) dst[n][k] = *(const PG8_LAS bf16x8*)(lds + PG8_SB(b, h) + boff + n * 2048 + k * 1024); } while (0)
#define PG8_MMA(ai, bj, At, Bt) do { __builtin_amdgcn_s_setprio(1); _Pragma("unroll") for (int m = 0; m < 4; ++m) _Pragma("unroll") for (int n = 0; n < 2; ++n) _Pragma("unroll") for (int k = 0; k < 2; ++k) \
        acc[ai][bj][m][n] = __builtin_amdgcn_mfma_f32_16x16x32_bf16(Bt[n][k], At[m][k], acc[ai][bj][m][n], 0, 0, 0); __builtin_amdgcn_s_setprio(0); } while (0)
#define PG8_WAIT_V(n) asm volatile("s_waitcnt vmcnt(" #n ")" ::: "memory")
#define PG8_WAIT_L(n) asm volatile("s_waitcnt lgkmcnt(" #n ")" ::: "memory")
#define PG8_BAR __builtin_amdgcn_s_barrier()
#define PG8_SCHED __builtin_amdgcn_sched_barrier(0)
    Unit cur, nxt; int ui = 0;
    if (!S.next(0, cur)) return;
    f32x4 acc[2][2][4][2];
#pragma unroll
    for (int a = 0; a < 2; ++a)
#pragma unroll
        for (int b = 0; b < 2; ++b)
#pragma unroll
            for (int m = 0; m < 4; ++m)
#pragma unroll
                for (int n = 0; n < 2; ++n) acc[a][b][m][n] = (f32x4){0.f, 0.f, 0.f, 0.f};
    bf16x8 At[4][2], B0[2][2], B1[2][2];
    const char* cA = (const char*)g.A + (size_t)cur.pm * tstep; const char* cB = (const char*)g.Bt + (size_t)cur.pn * tstep;
    S.a_ready(cur);
    if constexpr (SP2) {
        PG8_STAGE(PG8_SB(0, 0), cB, voffB); PG8_STAGE(PG8_SB(0, 1), cB + hstep, voffB); PG8_STAGE(PG8_SA(0, 0), cA, voffA); PG8_STAGE(PG8_SA(0, 1), cA + hstep, voffA);
        if (wr == 1) PG8_BAR;
        PG8_WAIT_V(2); PG8_BAR;
        PG8_STAGE(PG8_SB(1, 0), cB + kstep, voffB); PG8_STAGE(PG8_SA(1, 0), cA + kstep, voffA); PG8_STAGE(PG8_SB(1, 1), cB + hstep + kstep, voffB);
        PG8_WAIT_V(6); PG8_BAR;
    } else {
        PG8_STAGE(PG8_SB(0, 0), cB, voffB); PG8_STAGE(PG8_SA(0, 0), cA, voffA); PG8_STAGE(PG8_SB(0, 1), cB + hstep, voffB); PG8_STAGE(PG8_SA(0, 1), cA + hstep, voffA);
        if (wr == 1) PG8_BAR;
        PG8_WAIT_V(4); PG8_BAR;
        PG8_STAGE(PG8_SB(1, 0), cB + kstep, voffB); PG8_STAGE(PG8_SA(1, 0), cA + kstep, voffA); PG8_STAGE(PG8_SB(1, 1), cB + hstep + kstep, voffB);
        PG8_WAIT_V(6); PG8_BAR;
    }
    for (;;) {
        const bool has_next = S.next(ui + 1, nxt);
        const char* nA = has_next ? (const char*)g.A + (size_t)nxt.pm * tstep : cA; const char* nB = has_next ? (const char*)g.Bt + (size_t)nxt.pn * tstep : cB;
        for (int t = 0; t < nt; t += 2) {
            const bool last = (t == nt - 2);
            const char* a1 = cA + (size_t)(t + 1) * kstep;
            const char* a2 = last ? nA : cA + (size_t)(t + 2) * kstep; const char* b2 = last ? nB : cB + (size_t)(t + 2) * kstep;
            const char* a3 = a2 + kstep; const char* b3 = b2 + kstep;
            if (last && has_next) S.a_ready(nxt);
            if constexpr (SP2) {
            PG8_LDB(B0, 0, 0); PG8_LDB(B1, 0, 1); PG8_SCHED; PG8_LDA(At, 0, 0); PG8_STAGE(PG8_SA(1, 1), a1 + hstep, voffA);
            PG8_WAIT_V(8); PG8_WAIT_L(0); PG8_BAR; PG8_MMA(0, 0, At, B0); PG8_MMA(0, 1, At, B1); PG8_BAR; PG8_SCHED;
            PG8_LDA(At, 0, 1); PG8_STAGE(PG8_SB(0, 0), b2, voffB); PG8_STAGE(PG8_SB(0, 1), b2 + hstep, voffB); PG8_STAGE(PG8_SA(0, 0), a2, voffA);
            PG8_WAIT_V(8); PG8_WAIT_L(0); PG8_BAR; PG8_MMA(1, 0, At, B0); PG8_MMA(1, 1, At, B1); PG8_BAR; PG8_SCHED;
            PG8_LDB(B0, 1, 0); PG8_LDB(B1, 1, 1); PG8_SCHED; PG8_LDA(At, 1, 0); PG8_STAGE(PG8_SA(0, 1), a2 + hstep, voffA);
            PG8_WAIT_V(8); PG8_WAIT_L(0); PG8_BAR; PG8_MMA(0, 0, At, B0); PG8_MMA(0, 1, At, B1); PG8_BAR; PG8_SCHED;
            PG8_LDA(At, 1, 1); PG8_STAGE(PG8_SB(1, 0), b3, voffB); PG8_STAGE(PG8_SB(1, 1), b3 + hstep, voffB); PG8_STAGE(PG8_SA(1, 0), a3, voffA);
            PG8_WAIT_V(8); PG8_WAIT_L(0); PG8_BAR; PG8_MMA(1, 0, At, B0); PG8_MMA(1, 1, At, B1); PG8_BAR; PG8_SCHED;
            } else {
            PG8_LDB(B0, 0, 0); PG8_SCHED; PG8_LDA(At, 0, 0); PG8_STAGE(PG8_SA(1, 1), a1 + hstep, voffA);
            PG8_WAIT_L(8); PG8_BAR; PG8_WAIT_L(0); PG8_MMA(0, 0, At, B0); PG8_BAR; PG8_SCHED;
            PG8_LDB(B1, 0, 1); PG8_STAGE(PG8_SB(0, 0), b2, voffB);
            PG8_BAR; PG8_WAIT_L(0); PG8_MMA(0, 1, At, B1); PG8_BAR;
            PG8_LDA(At, 0, 1); PG8_STAGE(PG8_SA(0, 0), a2, voffA);
            PG8_BAR; PG8_WAIT_L(0); PG8_MMA(1, 0, At, B0); PG8_BAR; PG8_SCHED;
            PG8_STAGE(PG8_SB(0, 1), b2 + hstep, voffB);
            PG8_WAIT_V(6); PG8_BAR; PG8_MMA(1, 1, At, B1); PG8_BAR;
            PG8_LDB(B0, 1, 0); PG8_SCHED; PG8_LDA(At, 1, 0); PG8_STAGE(PG8_SA(0, 1), a2 + hstep, voffA);
            PG8_WAIT_L(8); PG8_BAR; PG8_WAIT_L(0); PG8_MMA(0, 0, At, B0); PG8_BAR; PG8_SCHED;
            PG8_LDB(B1, 1, 1); PG8_STAGE(PG8_SB(1, 0), b3, voffB);
            PG8_BAR; PG8_WAIT_L(0); PG8_MMA(0, 1, At, B1); PG8_BAR;
            PG8_LDA(At, 1, 1); PG8_STAGE(PG8_SA(1, 0), a3, voffA);
            PG8_BAR; PG8_WAIT_L(0); PG8_MMA(1, 0, At, B0); PG8_BAR; PG8_SCHED;
            PG8_STAGE(PG8_SB(1, 1), b3 + hstep, voffB);
            PG8_WAIT_V(6); PG8_BAR; PG8_MMA(1, 1, At, B1); PG8_BAR;
            }
        }
        if constexpr (ALIGN_EPI) { if (wr == 0) PG8_BAR; }
        if constexpr (!Epi::AFTER_DRAIN) { E(acc, cur, wr, wc, fr, fq); S.done(cur); }
        if (!has_next) break;
#pragma unroll
        for (int a = 0; a < 2; ++a)
#pragma unroll
            for (int b = 0; b < 2; ++b)
#pragma unroll
                for (int m = 0; m < 4; ++m)
#pragma unroll
                    for (int n = 0; n < 2; ++n) acc[a][b][m][n] = (f32x4){0.f, 0.f, 0.f, 0.f};
        cur = nxt; cA = nA; cB = nB; ++ui;
        if constexpr (ALIGN_EPI) { if (wr == 1) PG8_BAR; }
    }
    PG8_WAIT_V(0);
    if constexpr (!ALIGN_EPI) { if (wr == 0) PG8_BAR; }
    PG8_BAR;
    if constexpr (Epi::AFTER_DRAIN) { E.fused(acc, cur, wr, wc, fr, fq, lds, wid, lane); S.done(cur); }
#undef PG8_SA
#undef PG8_SB
#undef PG8_STAGE
#undef PG8_LDA
#undef PG8_LDB
#undef PG8_MMA
#undef PG8_WAIT_V
#undef PG8_WAIT_L
#undef PG8_BAR
#undef PG8_SCHED
}
}
#define GAS __attribute__((address_space(1)))
#define LAS __attribute__((address_space(3)))
typedef unsigned short bf16;
typedef unsigned v4u __attribute__((ext_vector_type(4)));
typedef float f32x4 __attribute__((ext_vector_type(4)));
typedef short bf16x8 __attribute__((ext_vector_type(8)));
typedef GAS unsigned gu32;
typedef GAS unsigned long long gu64;
#define RLX_AGENT __ATOMIC_RELAXED, __HIP_MEMORY_SCOPE_AGENT
#define LDS_WAIT() asm volatile("s_waitcnt lgkmcnt(0)" ::: "memory")
#define VM_WAIT() asm volatile("s_waitcnt vmcnt(0)" ::: "memory")
__device__ __forceinline__ unsigned long long rt() { return __builtin_amdgcn_s_memrealtime(); }
__device__ __forceinline__ unsigned f2bf(float f) { unsigned u = __builtin_bit_cast(unsigned, f); return (u + 0x7fffu + ((u >> 16) & 1u)) >> 16; }
__device__ __forceinline__ unsigned pk2(float lo, float hi) { return f2bf(lo) | (f2bf(hi) << 16); }

#define XB_TMO      128
#define XB_XCNT(j)  (256  + 64 * (j))
#define XB_XSUB(j)  (1280 + 64 * (j))
#define XB_XGEN(j)  (2304 + 64 * (j))
#define XB_TOP      3328
#define XB_TOPGEN   3392
#define XCD_BAR_WORDS 3456
#define XB_SPIN_CAP (1u << 24)

__device__ __forceinline__ unsigned xb_ld(unsigned* p)              { return __hip_atomic_load(p, __ATOMIC_RELAXED, __HIP_MEMORY_SCOPE_AGENT); }
__device__ __forceinline__ unsigned xb_add(unsigned* p, unsigned v) { return __hip_atomic_fetch_add(p, v, __ATOMIC_RELAXED, __HIP_MEMORY_SCOPE_AGENT); }
__device__ __forceinline__ unsigned xb_xcc_id() { return (unsigned)__builtin_amdgcn_s_getreg((3 << 11) | 20) & 0xFu; }
#define XB_SPIN(cond, bar) do { unsigned _sp = 0; while (cond) { __builtin_amdgcn_s_sleep(1); \
    if ((++_sp & 255u) == 0u) { if (xb_ld(&(bar)[XB_TMO])) break; if (_sp > XB_SPIN_CAP) { atomicAdd(&(bar)[XB_TMO], 1u); break; } } } } while (0)

struct XcdBarrier {
    unsigned* bar; unsigned x;
    volatile LAS unsigned* st;
};

__device__ __forceinline__ XcdBarrier xcd_barrier_post(unsigned* bar, volatile LAS unsigned* st) {
    XcdBarrier b; b.bar = bar; b.x = xb_xcc_id(); b.st = st;
    if (threadIdx.x == 0) (void)xb_add(&bar[XB_XCNT(b.x)], 1u);
    return b;
}
__device__ __forceinline__ void xcd_barrier_complete(unsigned* bar, unsigned x, unsigned& nloc, unsigned& nx) {
    const unsigned G = gridDim.x * gridDim.y * gridDim.z;
    unsigned sum, cnt, mine, sp = 0u;
    for (;;) {
        sum = 0u; cnt = 0u; mine = 0u;
#pragma unroll
        for (unsigned j = 0; j < 16; ++j) { const unsigned c = xb_ld(&bar[XB_XCNT(j)]); sum += c; cnt += (c > 0u) ? 1u : 0u; mine = (j == x) ? c : mine; }
        if (sum == G) break;
        __builtin_amdgcn_s_sleep(1);
        if ((++sp & 255u) == 0u) { if (xb_ld(&bar[XB_TMO])) break; if (sp > XB_SPIN_CAP) { atomicAdd(&bar[XB_TMO], 1u); break; } }
    }
    nloc = mine > 0u ? mine : 1u; nx = cnt > 0u ? cnt : 1u;
}

__device__ __forceinline__ void xcd_barrier(const XcdBarrier& b) {
    asm volatile("s_waitcnt vmcnt(0)" ::: "memory");
    __syncthreads();
    if (threadIdx.x == 0) {
        unsigned* bar = b.bar;
        __builtin_amdgcn_s_waitcnt(0);
        unsigned nloc = b.st[0], nx = b.st[1];
        if (nloc == 0u) { xcd_barrier_complete(bar, b.x, nloc, nx); b.st[0] = nloc; b.st[1] = nx; }
        const unsigned old = xb_add(&bar[XB_XSUB(b.x)], 1u);
        const unsigned gen = old / nloc;
        if (old + 1u == (gen + 1u) * nloc) {
            __builtin_amdgcn_fence(__ATOMIC_RELEASE, "agent");
            asm volatile("s_waitcnt vmcnt(0)" ::: "memory");
            const unsigned og = xb_add(&bar[XB_TOP], 1u);
            const unsigned tg = og / nx;
            if (og + 1u == (tg + 1u) * nx) xb_add(&bar[XB_TOPGEN], 1u);
            else XB_SPIN(xb_ld(&bar[XB_TOPGEN]) == tg, bar);
            __builtin_amdgcn_fence(__ATOMIC_ACQUIRE, "agent");
            xb_add(&bar[XB_XGEN(b.x)], 1u);
            asm volatile("s_waitcnt vmcnt(0)" ::: "memory");
        } else {
            XB_SPIN(xb_ld(&bar[XB_XGEN(b.x)]) == gen, bar);
            __builtin_amdgcn_fence(__ATOMIC_ACQUIRE, "agent");
            asm volatile("s_waitcnt vmcnt(0)" ::: "memory");
        }
    }
    __syncthreads();
}
constexpr int S = 8192, D = 2048, FF = 8192;
constexpr int A_H = 32, A_HD = 64, A_KV = 4, A_NQKV = 2560, A_WIN = 128;
constexpr int B_H = 16, B_HD = 128, B_KV = 4, B_NQKV = 3072, MB = 256, NBLK = S / MB;
constexpr float ALPHA = 1.4142135623730951f, LN_EPS = 1e-5f, LOG2E = 1.4426950408889634f;
constexpr float QS_A = 0.125f * LOG2E;
constexpr float QS_B = 0.08838834764831845f * LOG2E;
constexpr int NWAVES = 8, NTHR = 512;

constexpr size_t MiB = 1u << 20;
constexpr size_t WS_CTL = 0, CTL_ZERO_BYTES = 1 * MiB;
constexpr size_t WS_COSA = 1 * MiB, WS_SINA = 2 * MiB, WS_COSB = 3 * MiB, WS_SINB = 5 * MiB, WS_KBAR = 7 * MiB;
constexpr size_t WS_WQKV = 8 * MiB, WS_WO = 18 * MiB, WS_W1 = 26 * MiB  , WS_W2 = 90 * MiB  , WS_WQKVB = 154 * MiB, WS_WOB = 166 * MiB;
constexpr size_t WS_XB = 174 * MiB;
constexpr size_t WS_R = 206 * MiB;
constexpr size_t WS_Q = WS_R + 96 * MiB;
constexpr size_t WS_O = 334 * MiB;
constexpr size_t WS_K = 366 * MiB, WS_V = 370 * MiB;
constexpr size_t WS_KB = 374 * MiB, WS_VB = 382 * MiB;
constexpr size_t WS_C = 390 * MiB;
constexpr size_t WS_END = 486 * MiB;
constexpr int CW_TMO = 0, CW_BAR = 4096;

constexpr int RING_OFF = 0, RING_BYTES = 131072;
constexpr int LDSCTL_OFF = RING_BYTES, MISC_OFF = LDSCTL_OFF + 320;
constexpr int LDS_BYTES = 147456;

__device__ __forceinline__ float wave_sum(float v) {
#pragma unroll
    for (int o = 1; o < 64; o <<= 1) v += __shfl_xor(v, o);
    return v;
}
__device__ __forceinline__ void p0_transpose_item(const float* W, int K, int N, bf16* WT, int row_off, LAS float* scr, int item, int lane) {
    const int nblk = N / 32, kb = item / nblk, nb = item % nblk, k0 = 64 * kb, n0 = 32 * nb;
#pragma unroll 8
    for (int i = 0; i < 32; ++i) { const int kk = 2 * i + (lane >> 5); scr[kk * 33 + (lane & 31)] = W[(size_t)(k0 + kk) * N + n0 + (lane & 31)]; }
    LDS_WAIT(); asm volatile("" ::: "memory");
    const int c = lane & 7;
#pragma unroll
    for (int j = 0; j < 4; ++j) { const int n = (lane >> 3) + 8 * j; const LAS float* s = scr + (8 * c) * 33 + n;
        v4u o; o.x = pk2(s[0 * 33], s[1 * 33]); o.y = pk2(s[2 * 33], s[3 * 33]); o.z = pk2(s[4 * 33], s[5 * 33]); o.w = pk2(s[6 * 33], s[7 * 33]);
        *(GAS v4u*)(WT + (size_t)(row_off + n0 + n) * K + k0 + 8 * c) = o; }
    LDS_WAIT(); asm volatile("" ::: "memory");
}
struct Ctx { LAS unsigned char* lds; int tid, lane, wave, vcu, G; };

__device__ __forceinline__ void p0_prologue(const Ctx& c, const float* const* in, unsigned char* ws) {
    LAS float* scr = (LAS float*)(c.lds + RING_OFF + c.wave * 16384);
    const int gw = c.vcu * NWAVES + c.wave, NGW = c.G * NWAVES;
    constexpr int I_QKV = (D / 64) * (A_NQKV / 32), I_SQ = (D / 64) * (D / 32), I_KV = (D / 64) * (1024 / 32), I_W1 = (D / 64) * (FF / 32), I_W2 = (FF / 64) * (D / 32);
    constexpr int NITEMS = I_QKV + 3 * I_SQ + I_KV + 2 * I_W1 + 2 * I_W2;
    for (int it = gw; it < NITEMS; it += NGW) {
        int r = it;
        if (r < I_QKV) { p0_transpose_item(in[2], D, A_NQKV, (bf16*)(ws + WS_WQKV), 0, scr, r, c.lane); continue; } r -= I_QKV;
        if (r < I_SQ) { p0_transpose_item(in[5], D, D, (bf16*)(ws + WS_WO), 0, scr, r, c.lane); continue; } r -= I_SQ;
        if (r < I_SQ) { p0_transpose_item(in[6], D, D, (bf16*)(ws + WS_WQKVB), 0, scr, r, c.lane); continue; } r -= I_SQ;
        if (r < I_KV) { p0_transpose_item(in[8], D, 1024, (bf16*)(ws + WS_WQKVB), D, scr, r, c.lane); continue; } r -= I_KV;
        if (r < I_SQ) { p0_transpose_item(in[7], D, D, (bf16*)(ws + WS_WOB), 0, scr, r, c.lane); continue; } r -= I_SQ;
        if (r < I_W1) { p0_transpose_item(in[13], D, FF, (bf16*)(ws + WS_W1), 0, scr, r, c.lane); continue; } r -= I_W1;
        if (r < I_W1) { p0_transpose_item(in[13] + (size_t)D * FF, D, FF, (bf16*)(ws + WS_W1 + 32 * MiB), 0, scr, r, c.lane); continue; } r -= I_W1;
        if (r < I_W2) { p0_transpose_item(in[14], FF, D, (bf16*)(ws + WS_W2), 0, scr, r, c.lane); continue; } r -= I_W2;
        p0_transpose_item(in[14] + (size_t)D * FF, FF, D, (bf16*)(ws + WS_W2 + 32 * MiB), 0, scr, r, c.lane);
    }
    const int gt = c.vcu * NTHR + c.tid, NGT = c.G * NTHR;
    { const f32x4* x4 = (const f32x4*)in[0]; v4u* o = (v4u*)(ws + WS_XB);
      for (int i = gt; i < S * D / 8; i += NGT) { const f32x4 a = x4[2 * i], b = x4[2 * i + 1]; v4u w; w.x = pk2(a[0], a[1]); w.y = pk2(a[2], a[3]); w.z = pk2(b[0], b[1]); w.w = pk2(b[2], b[3]); o[i] = w; } }
    { const int* pos = (const int*)in[1]; float* cA = (float*)(ws + WS_COSA); float* sA = (float*)(ws + WS_SINA); float* cB = (float*)(ws + WS_COSB); float* sB = (float*)(ws + WS_SINB);
      for (int i = gt; i < S * 96; i += NGT) { const int s = i / 96, j = i % 96; const bool isA = j < 32; const int fi = isA ? j : j - 32; const double dd = isA ? 64.0 : 128.0;
          const double invf = exp2(-(double)(2 * fi) / dd * 13.287712379549449); const double ang = (double)pos[s] * invf;
          double t = ang * 0.15915494309189535; t -= rint(t); const double r = t * 6.283185307179586;
          const float cv = (float)cos(r), sv = (float)sin(r);
          if (isA) { cA[s * 32 + fi] = cv; sA[s * 32 + fi] = sv; } else { cB[s * 64 + fi] = cv; sB[s * 64 + fi] = sv; } } }
}

__device__ __forceinline__ void p_rope_a(const Ctx& c, const float* C, const float* bias, unsigned char* ws) {
    const int gt = c.vcu * NTHR + c.tid, NGT = c.G * NTHR;
    const float* cA = (const float*)(ws + WS_COSA); const float* sA = (const float*)(ws + WS_SINA);
    bf16* Q = (bf16*)(ws + WS_Q); bf16* K = (bf16*)(ws + WS_K); bf16* V = (bf16*)(ws + WS_V);
    for (int idx = gt; idx < S * 1280; idx += NGT) {
        const int s = idx / 1280, p = idx % 1280; const float* Cr = C + (size_t)s * A_NQKV;
        if (p < 1152) { const int h = p >> 5, d = p & 31; const int c0 = h * 64 + d;
            const float x1 = Cr[c0] + bias[c0], x2 = Cr[c0 + 32] + bias[c0 + 32]; const float cs = cA[s * 32 + d], sn = sA[s * 32 + d];
            float o1 = x1 * cs - x2 * sn, o2 = x2 * cs + x1 * sn;
            if (h < 32) { o1 *= QS_A; o2 *= QS_A; Q[(size_t)s * 2048 + c0] = (bf16)f2bf(o1); Q[(size_t)s * 2048 + c0 + 32] = (bf16)f2bf(o2); }
            else { const int kc = (h - 32) * 64 + d; K[(size_t)s * 256 + kc] = (bf16)f2bf(o1); K[(size_t)s * 256 + kc + 32] = (bf16)f2bf(o2); }
        } else { const int v0 = (p - 1152) * 2; const int c0 = 2304 + v0;
            *(unsigned*)(V + (size_t)s * 256 + v0) = pk2(Cr[c0] + bias[c0], Cr[c0 + 1] + bias[c0 + 1]); }
    }
}
__device__ __forceinline__ void p_rope_b(const Ctx& c, const float* C, unsigned char* ws) {
    const int gt = c.vcu * NTHR + c.tid, NGT = c.G * NTHR;
    const float* cB = (const float*)(ws + WS_COSB); const float* sB = (const float*)(ws + WS_SINB);
    bf16* Q = (bf16*)(ws + WS_Q); bf16* K = (bf16*)(ws + WS_KB); bf16* V = (bf16*)(ws + WS_VB);
    for (int idx = gt; idx < S * 1536; idx += NGT) {
        const int s = idx / 1536, p = idx % 1536; const float* Cr = C + (size_t)s * B_NQKV;
        if (p < 1280) { const int h = p >> 6, d = p & 63; const int c0 = h * 128 + d;
            const float x1 = Cr[c0], x2 = Cr[c0 + 64]; const float cs = cB[s * 64 + d], sn = sB[s * 64 + d];
            float o1 = x1 * cs - x2 * sn, o2 = x2 * cs + x1 * sn;
            if (h < 16) { o1 *= QS_B; o2 *= QS_B; Q[(size_t)s * 2048 + c0] = (bf16)f2bf(o1); Q[(size_t)s * 2048 + c0 + 64] = (bf16)f2bf(o2); }
            else { const int kc = (h - 16) * 128 + d; K[(size_t)s * 512 + kc] = (bf16)f2bf(o1); K[(size_t)s * 512 + kc + 64] = (bf16)f2bf(o2); }
        } else { const int v0 = (p - 1280) * 2; const int c0 = 2560 + v0;
            *(unsigned*)(V + (size_t)s * 512 + v0) = pk2(Cr[c0], Cr[c0 + 1]); }
    }
}
__device__ __forceinline__ float bf2f(unsigned short b) { return __builtin_bit_cast(float, (unsigned)b << 16); }
__device__ __forceinline__ void unpack8(const v4u w, float* f) {
    f[0] = __builtin_bit_cast(float, w.x << 16); f[1] = __builtin_bit_cast(float, w.x & 0xffff0000u);
    f[2] = __builtin_bit_cast(float, w.y << 16); f[3] = __builtin_bit_cast(float, w.y & 0xffff0000u);
    f[4] = __builtin_bit_cast(float, w.z << 16); f[5] = __builtin_bit_cast(float, w.z & 0xffff0000u);
    f[6] = __builtin_bit_cast(float, w.w << 16); f[7] = __builtin_bit_cast(float, w.w & 0xffff0000u);
}
__device__ __forceinline__ void p_swa_naive(const Ctx& c, const float* sinks, unsigned char* ws) {
    const int gt = c.vcu * NTHR + c.tid, NGT = c.G * NTHR;
    const bf16* Q = (const bf16*)(ws + WS_Q); const bf16* K = (const bf16*)(ws + WS_K); const bf16* V = (const bf16*)(ws + WS_V); bf16* O = (bf16*)(ws + WS_O);
    for (int idx = gt; idx < S * A_H; idx += NGT) {
        const int s = idx >> 5, h = idx & 31, kvh = h >> 3;
        float q[64];
#pragma unroll
        for (int i = 0; i < 8; ++i) unpack8(*(const v4u*)(Q + (size_t)s * 2048 + h * 64 + 8 * i), q + 8 * i);
        float m = sinks[h] * LOG2E, l = 1.f; float o[64];
#pragma unroll
        for (int i = 0; i < 64; ++i) o[i] = 0.f;
        const int j0 = s - (A_WIN - 1) < 0 ? 0 : s - (A_WIN - 1);
        for (int j = j0; j <= s; ++j) {
            float sc = 0.f;
#pragma unroll
            for (int i = 0; i < 8; ++i) { float kf[8]; unpack8(*(const v4u*)(K + (size_t)j * 256 + kvh * 64 + 8 * i), kf);
#pragma unroll
                for (int e = 0; e < 8; ++e) sc += q[8 * i + e] * kf[e]; }
            const float mn = fmaxf(m, sc), corr = exp2f(m - mn), p = exp2f(sc - mn); m = mn; l = l * corr + p;
#pragma unroll
            for (int i = 0; i < 8; ++i) { float vf[8]; unpack8(*(const v4u*)(V + (size_t)j * 256 + kvh * 64 + 8 * i), vf);
#pragma unroll
                for (int e = 0; e < 8; ++e) o[8 * i + e] = o[8 * i + e] * corr + p * vf[e]; }
        }
        const float rl = 1.f / l;
#pragma unroll
        for (int i = 0; i < 8; ++i) { v4u w; w.x = pk2(o[8 * i] * rl, o[8 * i + 1] * rl); w.y = pk2(o[8 * i + 2] * rl, o[8 * i + 3] * rl); w.z = pk2(o[8 * i + 4] * rl, o[8 * i + 5] * rl); w.w = pk2(o[8 * i + 6] * rl, o[8 * i + 7] * rl);
            *(v4u*)(O + (size_t)s * 2048 + h * 64 + 8 * i) = w; }
    }
}
__device__ __forceinline__ void p_kbar(const Ctx& c, unsigned char* ws) {
    const int gt = c.vcu * NTHR + c.tid, NGT = c.G * NTHR;
    const bf16* K = (const bf16*)(ws + WS_KB); float* kbar = (float*)(ws + WS_KBAR);
    for (int idx = gt; idx < B_KV * NBLK * B_HD; idx += NGT) { const int d = idx & 127, n = (idx >> 7) & 31, kvh = idx >> 12; float a = 0.f;
        for (int r = 0; r < MB; ++r) a += bf2f(K[(size_t)(n * MB + r) * 512 + kvh * 128 + d]);
        kbar[idx] = a * (1.f / MB); }
}
__device__ __forceinline__ float wave_max(float v) {
#pragma unroll
    for (int o = 1; o < 64; o <<= 1) v = fmaxf(v, __shfl_xor(v, o));
    return v;
}
__device__ __forceinline__ void p_moba_naive(const Ctx& c, unsigned char* ws) {
    const int gw = c.vcu * NWAVES + c.wave, NGW = c.G * NWAVES, lane = c.lane;
    const bf16* Q = (const bf16*)(ws + WS_Q); const bf16* K = (const bf16*)(ws + WS_KB); const bf16* V = (const bf16*)(ws + WS_VB); bf16* O = (bf16*)(ws + WS_O);
    const float* kbar = (const float*)(ws + WS_KBAR);
    LAS float* qs = (LAS float*)(c.lds + c.wave * 8192); LAS float* ps = qs + 128;
    for (int task = gw; task < S * B_H; task += NGW) {
        const int s = task >> 4, h = task & 15, kvh = h >> 2, qb = s >> 8;
        { const unsigned w = *(const unsigned*)(Q + (size_t)s * 2048 + h * 128 + 2 * lane); qs[2 * lane] = __builtin_bit_cast(float, w << 16); qs[2 * lane + 1] = __builtin_bit_cast(float, w & 0xffff0000u); }
        LDS_WAIT(); asm volatile("" ::: "memory");
        float g = -INFINITY;
        if (lane < qb) { const float* kb = kbar + (size_t)(kvh * NBLK + lane) * 128; float a = 0.f; for (int d = 0; d < 128; ++d) a += qs[d] * kb[d]; g = a; }
        int sel[4];
#pragma unroll
        for (int r = 0; r < 3; ++r) { float bv = g; int bi = lane;
#pragma unroll
            for (int o = 1; o < 64; o <<= 1) { const float ov = __shfl_xor(bv, o); const int oi = __shfl_xor(bi, o); if (ov > bv || (ov == bv && oi < bi)) { bv = ov; bi = oi; } }
            sel[r] = (bv == -INFINITY) ? -1 : bi; if (lane == bi) g = -INFINITY; }
        sel[3] = qb;
        float sc[4][4]; float mx = -INFINITY;
#pragma unroll
        for (int b = 0; b < 4; ++b) {
#pragma unroll
            for (int t = 0; t < 4; ++t) { sc[b][t] = -INFINITY;
                if (sel[b] >= 0) { const int j = sel[b] * MB + lane + 64 * t; const bf16* kr = K + (size_t)j * 512 + kvh * 128; float a = 0.f;
                    for (int i = 0; i < 16; ++i) { float kf[8]; unpack8(*(const v4u*)(kr + 8 * i), kf);
#pragma unroll
                        for (int e = 0; e < 8; ++e) a += qs[8 * i + e] * kf[e]; }
                    if (b == 3 && j > s) a = -INFINITY; sc[b][t] = a; mx = fmaxf(mx, a); } } }
        mx = wave_max(mx); float ls = 0.f;
#pragma unroll
        for (int b = 0; b < 4; ++b)
#pragma unroll
            for (int t = 0; t < 4; ++t) { const float p = exp2f(sc[b][t] - mx); ls += p; ps[b * 256 + lane + 64 * t] = p; }
        ls = wave_sum(ls);
        LDS_WAIT(); asm volatile("" ::: "memory");
        float o0 = 0.f, o1 = 0.f;
#pragma unroll
        for (int b = 0; b < 4; ++b) { if (sel[b] < 0) continue; const bf16* vr = V + (size_t)(sel[b] * MB) * 512 + kvh * 128 + 2 * lane;
            for (int jj = 0; jj < MB; ++jj) { const float p = ps[b * 256 + jj]; const unsigned w = *(const unsigned*)(vr + (size_t)jj * 512);
                o0 += p * __builtin_bit_cast(float, w << 16); o1 += p * __builtin_bit_cast(float, w & 0xffff0000u); } }
        const float rl = 1.f / ls;
        *(unsigned*)(O + (size_t)s * 2048 + h * 128 + 2 * lane) = pk2(o0 * rl, o1 * rl);
        LDS_WAIT(); asm volatile("" ::: "memory");
    }
}
__device__ __forceinline__ void p_ln(const Ctx& c, const float* res, const float* C, const float* g, const float* b, float* out, bf16* xb) {
    const int gw = c.vcu * NWAVES + c.wave, NGW = c.G * NWAVES, lane = c.lane;
    for (int row = gw; row < S; row += NGW) {
        const f32x4* r4 = (const f32x4*)(res + (size_t)row * D) + lane; const f32x4* c4 = (const f32x4*)(C + (size_t)row * D) + lane;
        f32x4 v[8]; float sm = 0.f;
#pragma unroll
        for (int j = 0; j < 8; ++j) { v[j] = r4[64 * j] * ALPHA + c4[64 * j]; sm += (v[j][0] + v[j][1]) + (v[j][2] + v[j][3]); }
        const float mean = wave_sum(sm) * (1.f / D); float s2 = 0.f;
#pragma unroll
        for (int j = 0; j < 8; ++j) { v[j] = v[j] - mean; s2 += (v[j][0] * v[j][0] + v[j][1] * v[j][1]) + (v[j][2] * v[j][2] + v[j][3] * v[j][3]); }
        const float rstd = 1.f / sqrtf(wave_sum(s2) * (1.f / D) + LN_EPS);
        f32x4* o4 = (f32x4*)(out + (size_t)row * D) + lane; unsigned long long* o8 = (unsigned long long*)(xb + (size_t)row * D) + lane;
#pragma unroll
        for (int j = 0; j < 8; ++j) { const f32x4 gg = ((const f32x4*)g)[lane + 64 * j], bb = ((const f32x4*)b)[lane + 64 * j]; const f32x4 y = v[j] * rstd * gg + bb;
            o4[64 * j] = y; o8[64 * j] = (unsigned long long)pk2(y[0], y[1]) | ((unsigned long long)pk2(y[2], y[3]) << 32); }
    }
}

typedef float f32x16 __attribute__((ext_vector_type(16)));
typedef short s16x4 __attribute__((ext_vector_type(4)));
typedef short v4i16_t __attribute__((ext_vector_type(4)));
typedef unsigned v2u __attribute__((ext_vector_type(2)));
__device__ __forceinline__ unsigned off_b(unsigned row, unsigned ch) { return 256u * row + 16u * (ch ^ (((row & 3u) << 2) | ((row >> 2) & 3u))); }
__device__ __forceinline__ int crow(int r, int hi) { return (r & 3) + 8 * (r >> 2) + 4 * hi; }
__device__ __forceinline__ s16x4 vtr(LAS const unsigned char* p) { return __builtin_bit_cast(s16x4, __builtin_amdgcn_ds_read_tr16_b64_v4i16((LAS v4i16_t*)p)); }
__device__ __forceinline__ unsigned cvtpk(float lo, float hi) { typedef float f2 __attribute__((ext_vector_type(2))); typedef __bf16 b2 __attribute__((ext_vector_type(2))); f2 v = {lo, hi}; b2 b = __builtin_convertvector(v, b2); return __builtin_bit_cast(unsigned, b); }
__device__ __forceinline__ bf16x8 packp(const f32x16& s, int b) { v4u w; w.x = cvtpk(s[b], s[b + 1]); w.y = cvtpk(s[b + 2], s[b + 3]); w.z = cvtpk(s[b + 4], s[b + 5]); w.w = cvtpk(s[b + 6], s[b + 7]); return __builtin_bit_cast(bf16x8, w); }
__device__ __forceinline__ bf16x8 vfrag(LAS const unsigned char* Vimg, int row0, int c, int lane) {
    const int h = lane >> 5, blk = (lane >> 4) & 1, q = (lane & 15) >> 2, p = lane & 3;
    const s16x4 lo = vtr(Vimg + off_b(row0 + 4 * h + q, 4 * c + 2 * blk + (p >> 1)) + 8 * (p & 1));
    const s16x4 hi = vtr(Vimg + off_b(row0 + 8 + 4 * h + q, 4 * c + 2 * blk + (p >> 1)) + 8 * (p & 1));
    return (bf16x8){lo[0], lo[1], lo[2], lo[3], hi[0], hi[1], hi[2], hi[3]};
}
__device__ __forceinline__ float xswap_max(float v) { return fmaxf(v, __shfl_xor(v, 32)); }

__device__ __forceinline__ void p_swa(const Ctx& c, const float* sinks, unsigned char* ws) {
    const bf16* Q = (const bf16*)(ws + WS_Q); const bf16* K = (const bf16*)(ws + WS_K); const bf16* V = (const bf16*)(ws + WS_V); bf16* O = (bf16*)(ws + WS_O);
    LAS unsigned char* Kimg = c.lds; LAS unsigned char* Vimg = c.lds + 40960;
    const int lane = c.lane, r32 = lane & 31, hh = lane >> 5;
    constexpr int NU = (S / 32) * A_KV; const int u0 = (int)(((long)c.vcu * NU) / c.G), u1 = (int)(((long)(c.vcu + 1) * NU) / c.G);
    for (int u = u0; u < u1; ++u) {
        const int kvh = u / (S / 32), s0 = (u % (S / 32)) * 32, kbase = s0 - 128;
        const int h = kvh * 8 + c.wave;
        bf16x8 qf[4];
#pragma unroll
        for (int d0 = 0; d0 < 4; ++d0) qf[d0] = *(const bf16x8*)(Q + (size_t)(s0 + r32) * 2048 + h * 64 + 16 * d0 + 8 * hh);
        __syncthreads();
        for (int n = c.tid; n < 160 * 8; n += NTHR) { const int row = n >> 3, ch = n & 7, kp = kbase + row;
            if (kp >= 0) { *(LAS v4u*)(Kimg + off_b(row, ch)) = *(const v4u*)(K + (size_t)kp * 256 + kvh * 64 + 8 * ch); *(LAS v4u*)(Vimg + off_b(row, ch)) = *(const v4u*)(V + (size_t)kp * 256 + kvh * 64 + 8 * ch); } }
        __syncthreads();
        f32x16 st[5]; const int t0 = kbase < 0 ? (-kbase) >> 5 : 0;
#pragma unroll
        for (int t = 0; t < 5; ++t) { f32x16 a;
#pragma unroll
            for (int r = 0; r < 16; ++r) a[r] = 0.f;
            if (t >= t0) {
#pragma unroll
                for (int d0 = 0; d0 < 4; ++d0) { const bf16x8 kf = *(LAS const bf16x8*)(Kimg + off_b(32 * t + r32, 2 * d0 + hh)); a = __builtin_amdgcn_mfma_f32_32x32x16_bf16(kf, qf[d0], a, 0, 0, 0); } }
            st[t] = a; }
        float m = sinks[h] * LOG2E; const float sk2 = m;
#pragma unroll
        for (int t = 0; t < 5; ++t)
#pragma unroll
            for (int r = 0; r < 16; ++r) { const int cr = crow(r, hh); bool ok = t >= t0; if (t == 0) ok = ok && (cr > r32); if (t == 4) ok = ok && (cr <= r32);
                st[t][r] = ok ? st[t][r] : -INFINITY; m = fmaxf(m, st[t][r]); }
        m = xswap_max(m); float l = 0.f;
#pragma unroll
        for (int t = 0; t < 5; ++t)
#pragma unroll
            for (int r = 0; r < 16; ++r) { const float p = exp2f(st[t][r] - m); st[t][r] = p; l += p; }
        l += __shfl_xor(l, 32); l += exp2f(sk2 - m);
        f32x16 o[2];
#pragma unroll
        for (int cc = 0; cc < 2; ++cc)
#pragma unroll
            for (int r = 0; r < 16; ++r) o[cc][r] = 0.f;
#pragma unroll
        for (int t = 0; t < 5; ++t) { if (t < t0) continue;
#pragma unroll
            for (int ks = 0; ks < 2; ++ks) { const bf16x8 pf = packp(st[t], 8 * ks);
#pragma unroll
                for (int cc = 0; cc < 2; ++cc) { const bf16x8 vf = vfrag(Vimg, 32 * t + 16 * ks, cc, lane); o[cc] = __builtin_amdgcn_mfma_f32_32x32x16_bf16(vf, pf, o[cc], 0, 0, 0); } } }
        const float rl = 1.f / l; bf16* orow = O + (size_t)(s0 + r32) * 2048 + h * 64;
#pragma unroll
        for (int cc = 0; cc < 2; ++cc)
#pragma unroll
            for (int a = 0; a < 4; ++a) { v2u w; w.x = cvtpk(o[cc][4 * a] * rl, o[cc][4 * a + 1] * rl); w.y = cvtpk(o[cc][4 * a + 2] * rl, o[cc][4 * a + 3] * rl); *(v2u*)(orow + 32 * cc + 8 * a + 4 * hh) = w; }
    }
    __syncthreads();
}

constexpr int CW_LCNT = 8192;
constexpr size_t WS_ML = WS_C;
constexpr size_t WS_LIST = WS_C + 4 * MiB;
constexpr int LCAP = 32768;
constexpr size_t WS_PART = WS_R;
__device__ __forceinline__ void p_gate(const Ctx& c, unsigned char* ws) {
    const bf16* Q = (const bf16*)(ws + WS_Q); const float* kbar = (const float*)(ws + WS_KBAR); unsigned* lists = (unsigned*)(ws + WS_LIST); unsigned* cnt = (unsigned*)(ws + WS_CTL) + CW_LCNT;
    const int gw = c.vcu * NWAVES + c.wave, NGW = c.G * NWAVES, lane = c.lane;
    for (int task = gw; task < (S / 64) * B_H; task += NGW) {
        const int qseg = task >> 4, h = task & 15, kvh = h >> 2, hl = h & 3, qb = qseg >> 2, s = qseg * 64 + lane;
        if (qb == 0) continue;
        v4u qp[16];
#pragma unroll
        for (int i = 0; i < 16; ++i) qp[i] = *(const v4u*)(Q + (size_t)s * 2048 + h * 128 + 8 * i);
        float v0 = -INFINITY, v1 = -INFINITY, v2 = -INFINITY; int i0 = -1, i1 = -1, i2 = -1;
        for (int n = 0; n < qb; ++n) { const float* kb = kbar + (size_t)(kvh * NBLK + n) * 128; float g = 0.f;
#pragma unroll
            for (int i = 0; i < 16; ++i) { float f[8]; unpack8(qp[i], f);
#pragma unroll
                for (int e = 0; e < 8; ++e) g += f[e] * kb[8 * i + e]; }
            if (g > v0) { v2 = v1; i2 = i1; v1 = v0; i1 = i0; v0 = g; i0 = n; } else if (g > v1) { v2 = v1; i2 = i1; v1 = g; i1 = n; } else if (g > v2) { v2 = g; i2 = n; } }
        for (int n = 0; n < qb; ++n) {
            const unsigned long long b0 = __ballot(i0 == n), b1 = __ballot(i1 == n), b2 = __ballot(i2 == n);
            const int n0 = __popcll(b0), n1 = __popcll(b1), n2 = __popcll(b2), tot = n0 + n1 + n2;
            if (tot == 0) continue;
            unsigned base = 0; if (lane == 0) base = __hip_atomic_fetch_add(cnt + kvh * NBLK + n, (unsigned)tot, __ATOMIC_RELAXED, __HIP_MEMORY_SCOPE_AGENT);
            base = __builtin_amdgcn_readfirstlane(base);
            unsigned* L = lists + (size_t)(kvh * NBLK + n) * LCAP;
            const unsigned long long lt = (1ull << lane) - 1ull;
            if (i0 == n) L[base + __popcll(b0 & lt)] = (unsigned)s | ((unsigned)hl << 13) | (0u << 15);
            if (i1 == n) L[base + n0 + __popcll(b1 & lt)] = (unsigned)s | ((unsigned)hl << 13) | (1u << 15);
            if (i2 == n) L[base + n0 + n1 + __popcll(b2 & lt)] = (unsigned)s | ((unsigned)hl << 13) | (2u << 15);
        }
    }
}
template <bool CAUSAL>
__device__ __forceinline__ void moba_core(LAS const unsigned char* Kimg, LAS const unsigned char* Vimg, const bf16x8 (&qf)[8], int qloc, int nch, int lane, float& m_out, float& l_out, f32x16 (&o)[4]) {
    const int r32 = lane & 31, hh = lane >> 5; float m = -INFINITY, l = 0.f;
#pragma unroll
    for (int cc = 0; cc < 4; ++cc)
#pragma unroll
        for (int r = 0; r < 16; ++r) o[cc][r] = 0.f;
    for (int ck = 0; ck < nch; ++ck) {
        f32x16 s0, s1;
#pragma unroll
        for (int r = 0; r < 16; ++r) { s0[r] = 0.f; s1[r] = 0.f; }
#pragma unroll
        for (int d0 = 0; d0 < 8; ++d0) { const bf16x8 k0 = *(LAS const bf16x8*)(Kimg + off_b(64 * ck + r32, 2 * d0 + hh)), k1 = *(LAS const bf16x8*)(Kimg + off_b(64 * ck + 32 + r32, 2 * d0 + hh));
            s0 = __builtin_amdgcn_mfma_f32_32x32x16_bf16(k0, qf[d0], s0, 0, 0, 0); s1 = __builtin_amdgcn_mfma_f32_32x32x16_bf16(k1, qf[d0], s1, 0, 0, 0); }
        float rm = -INFINITY;
#pragma unroll
        for (int r = 0; r < 16; ++r) { if (CAUSAL) { const int kv = 64 * ck + crow(r, hh); if (kv > qloc) s0[r] = -INFINITY; if (kv + 32 > qloc) s1[r] = -INFINITY; } rm = fmaxf(rm, fmaxf(s0[r], s1[r])); }
        rm = xswap_max(rm);
        const float mn = fmaxf(m, rm), msafe = (mn == -INFINITY) ? 0.f : mn, alpha = exp2f(m - msafe); float ps = 0.f;
#pragma unroll
        for (int r = 0; r < 16; ++r) { s0[r] = exp2f(s0[r] - msafe); s1[r] = exp2f(s1[r] - msafe); ps += s0[r] + s1[r]; }
        l = l * alpha + ps; m = mn;
        if (__any(alpha != 1.f)) {
#pragma unroll
            for (int cc = 0; cc < 4; ++cc)
#pragma unroll
                for (int r = 0; r < 16; ++r) o[cc][r] *= alpha; }
#pragma unroll
        for (int kt = 0; kt < 2; ++kt)
#pragma unroll
            for (int ks = 0; ks < 2; ++ks) { const bf16x8 pf = packp(kt ? s1 : s0, 8 * ks);
#pragma unroll
                for (int cc = 0; cc < 4; ++cc) { const bf16x8 vf = vfrag(Vimg, 64 * ck + 32 * kt + 16 * ks, cc, lane); o[cc] = __builtin_amdgcn_mfma_f32_32x32x16_bf16(vf, pf, o[cc], 0, 0, 0); } }
    }
    l += __shfl_xor(l, 32); m_out = m; l_out = l;
}
__device__ __forceinline__ void moba_load_block(const Ctx& c, const bf16* Kg, const bf16* Vg, int kvh, int j) {
    LAS unsigned char* Kimg = c.lds; LAS unsigned char* Vimg = c.lds + 65536;
#pragma unroll
    for (int i = 0; i < 8; ++i) { const int n = c.tid + NTHR * i, row = n >> 4, ch = n & 15; const size_t g = (size_t)(j * MB + row) * 512 + kvh * 128 + 8 * ch;
        *(LAS v4u*)(Kimg + off_b(row, ch)) = *(const v4u*)(Kg + g); *(LAS v4u*)(Vimg + off_b(row, ch)) = *(const v4u*)(Vg + g); }
}
__device__ __forceinline__ void p_moba_past(const Ctx& c, unsigned char* ws) {
    const bf16* Q = (const bf16*)(ws + WS_Q); const bf16* Kg = (const bf16*)(ws + WS_KB); const bf16* Vg = (const bf16*)(ws + WS_VB);
    const unsigned* lists = (const unsigned*)(ws + WS_LIST); const unsigned* cnt = (const unsigned*)(ws + WS_CTL) + CW_LCNT;
    bf16* part = (bf16*)(ws + WS_PART); float* ml = (float*)(ws + WS_ML);
    LAS int* pre = (LAS int*)(c.lds + 132096);
    const int lane = c.lane, r32 = lane & 31, hh = lane >> 5;
    if (c.tid < 128) pre[129 + c.tid] = (int)__hip_atomic_load(cnt + c.tid, __ATOMIC_RELAXED, __HIP_MEMORY_SCOPE_AGENT);
    __syncthreads();
    if (c.tid == 0) { int a = 0; for (int i = 0; i < 128; ++i) { pre[i] = a; a += (pre[129 + i] + 255) >> 8; } pre[128] = a; }
    __syncthreads();
    const int T = pre[128]; const int it0 = (int)(((long)c.vcu * T) / c.G), it1 = (int)(((long)(c.vcu + 1) * T) / c.G);
    int curl = -1, li = 0;
    for (int it = it0; it < it1; ++it) {
        while (pre[li + 1] <= it) ++li;
        const int kvh = li >> 5, j = li & 31, n = pre[129 + li], base = (it - pre[li]) * 256 + 32 * c.wave;
        if (li != curl) { __syncthreads(); moba_load_block(c, Kg, Vg, kvh, j); __syncthreads(); curl = li; }
        if (base >= n) continue;
        const int idx = base + r32; const bool valid = idx < n; const unsigned e = lists[(size_t)li * LCAP + (valid ? idx : n - 1)];
        const int q = e & 8191, h16 = kvh * 4 + ((e >> 13) & 3), rank = e >> 15;
        bf16x8 qf[8];
#pragma unroll
        for (int d0 = 0; d0 < 8; ++d0) qf[d0] = *(const bf16x8*)(Q + (size_t)q * 2048 + h16 * 128 + 16 * d0 + 8 * hh);
        float m, l; f32x16 o[4];
        moba_core<false>(c.lds, c.lds + 65536, qf, 0, 4, lane, m, l, o);
        if (valid) { const size_t slot = ((size_t)rank * S + q) * 16 + h16;
            if (hh == 0) { ml[2 * slot] = m; ml[2 * slot + 1] = l; }
            bf16* po = part + slot * 128;
#pragma unroll
            for (int cc = 0; cc < 4; ++cc)
#pragma unroll
                for (int a = 0; a < 4; ++a) { v2u w; w.x = cvtpk(o[cc][4 * a], o[cc][4 * a + 1]); w.y = cvtpk(o[cc][4 * a + 2], o[cc][4 * a + 3]); *(v2u*)(po + 32 * cc + 8 * a + 4 * hh) = w; } }
    }
    __syncthreads();
}
__device__ __forceinline__ void p_moba_own(const Ctx& c, unsigned char* ws) {
    const bf16* Q = (const bf16*)(ws + WS_Q); const bf16* Kg = (const bf16*)(ws + WS_KB); const bf16* Vg = (const bf16*)(ws + WS_VB); bf16* O = (bf16*)(ws + WS_O);
    const bf16* part = (const bf16*)(ws + WS_PART); const float* ml = (const float*)(ws + WS_ML);
    const int lane = c.lane, r32 = lane & 31, hh = lane >> 5;
    constexpr int T = B_H * NBLK; const int it0 = (int)(((long)c.vcu * T) / c.G), it1 = (int)(((long)(c.vcu + 1) * T) / c.G);
    int curk = -1;
    for (int it = it0; it < it1; ++it) {
        const int kvh = it >> 7, qb = (it >> 2) & 31, h16 = kvh * 4 + (it & 3);
        if ((it >> 2) != curk) { __syncthreads(); moba_load_block(c, Kg, Vg, kvh, qb); __syncthreads(); curk = it >> 2; }
        const int qloc = 32 * c.wave + r32, q = qb * MB + qloc;
        bf16x8 qf[8];
#pragma unroll
        for (int d0 = 0; d0 < 8; ++d0) qf[d0] = *(const bf16x8*)(Q + (size_t)q * 2048 + h16 * 128 + 16 * d0 + 8 * hh);
        float m, l; f32x16 o[4];
        moba_core<true>(c.lds, c.lds + 65536, qf, qloc, (32 * c.wave + 31) / 64 + 1, lane, m, l, o);
        const int nr = qb < 3 ? qb : 3; float mp[3], lp[3]; float M = m;
#pragma unroll
        for (int r = 0; r < 3; ++r) { mp[r] = -INFINITY; lp[r] = 0.f; if (r < nr) { const size_t slot = ((size_t)r * S + q) * 16 + h16; mp[r] = ml[2 * slot]; lp[r] = ml[2 * slot + 1]; M = fmaxf(M, mp[r]); } }
        const float w0 = exp2f(m - M); float L = l * w0;
#pragma unroll
        for (int cc = 0; cc < 4; ++cc)
#pragma unroll
            for (int r = 0; r < 16; ++r) o[cc][r] *= w0;
#pragma unroll
        for (int r = 0; r < 3; ++r) { if (r < nr) { const float w = exp2f(mp[r] - M); L += lp[r] * w; const bf16* po = part + (((size_t)r * S + q) * 16 + h16) * 128;
#pragma unroll
                for (int cc = 0; cc < 4; ++cc)
#pragma unroll
                    for (int a = 0; a < 4; ++a) { const v2u pw = *(const v2u*)(po + 32 * cc + 8 * a + 4 * hh);
                        o[cc][4 * a] += w * __builtin_bit_cast(float, pw.x << 16); o[cc][4 * a + 1] += w * __builtin_bit_cast(float, pw.x & 0xffff0000u);
                        o[cc][4 * a + 2] += w * __builtin_bit_cast(float, pw.y << 16); o[cc][4 * a + 3] += w * __builtin_bit_cast(float, pw.y & 0xffff0000u); } } }
        const float rl = 1.f / L; bf16* orow = O + (size_t)q * 2048 + h16 * 128;
#pragma unroll
        for (int cc = 0; cc < 4; ++cc)
#pragma unroll
            for (int a = 0; a < 4; ++a) { v2u w; w.x = cvtpk(o[cc][4 * a] * rl, o[cc][4 * a + 1] * rl); w.y = cvtpk(o[cc][4 * a + 2] * rl, o[cc][4 * a + 3] * rl); *(v2u*)(orow + 32 * cc + 8 * a + 4 * hh) = w; }
    }
    __syncthreads();
}

struct Args { const float* in[15]; float* out; unsigned char* ws; int ph_lo, ph_hi, li, pad; };
constexpr int N_PHASES = 20;
#ifndef MK_N_LAUNCHES
#define MK_N_LAUNCHES 1
#endif
__global__ void __launch_bounds__(NTHR, 2) fwd(Args args) {
    extern __shared__ __attribute__((aligned(16))) unsigned char lds[];
    Ctx c; c.lds = (LAS unsigned char*)lds; c.tid = threadIdx.x; c.lane = c.tid & 63; c.wave = __builtin_amdgcn_readfirstlane(c.tid >> 6);
    c.G = gridDim.x; { const int bx = blockIdx.x; c.vcu = (c.G % 8 == 0) ? (bx % 8) * (c.G / 8) + bx / 8 : bx; }
    volatile LAS unsigned* MISC = (volatile LAS unsigned*)(c.lds + MISC_OFF);
    unsigned char* ws = args.ws; gu32* ctl = (gu32*)(ws + WS_CTL);
    for (int u = c.tid; u < (LDS_BYTES - LDSCTL_OFF) / 4; u += NTHR) ((LAS unsigned*)(c.lds + LDSCTL_OFF))[u] = 0u;
    __syncthreads();
    XcdBarrier bar; bar.bar = (unsigned*)(ctl + CW_BAR) + args.li * XCD_BAR_WORDS; bar.x = 0; bar.st = nullptr;
    if (MK_N_LAUNCHES == 1) bar = xcd_barrier_post((unsigned*)(ctl + CW_BAR), MISC + 8);
    const int lo = args.ph_lo, hi = args.ph_hi;
#define IN(k) (lo <= (k) && (k) < hi)
#define SEAM(k) do { if (IN(k) && IN((k) + 1)) xcd_barrier(bar); } while (0)
    const float* const* in = args.in; float* out = args.out;
    float* C = (float*)(ws + WS_C); bf16* XB = (bf16*)(ws + WS_XB); bf16* HID = (bf16*)(ws + WS_R); bf16* OB = (bf16*)(ws + WS_O);
    typedef pg8::bf16_t pb;
#define GEMM_F32(Aptr, Bptr, Nn, Kk) do { pg8::Gemm g{(const pb*)(Aptr), (const pb*)(Bptr), S, (Nn), (Kk)}; pg8::StaticOrder So; So.init(S, (Nn), c.G, (int)blockIdx.x); pg8::EpiF32 E{C, (Nn)}; \
        pg8::gemm_phase<pg8::EpiF32, pg8::StaticOrder, true, true>(c.lds + RING_OFF, g, So, E); } while (0)
#define GEMM_RELU2(Aptr, Bptr, Nn, Kk) do { pg8::Gemm g{(const pb*)(Aptr), (const pb*)(Bptr), S, (Nn), (Kk)}; pg8::StaticOrder So; So.init(S, (Nn), c.G, (int)blockIdx.x); pg8::EpiRelu2 E{(pb*)HID, (Nn)}; \
        pg8::gemm_phase<pg8::EpiRelu2, pg8::StaticOrder, true, true>(c.lds + RING_OFF, g, So, E); } while (0)

    if (IN(0)) p0_prologue(c, in, ws);
    SEAM(0);
    if (IN(1)) GEMM_F32(XB, ws + WS_WQKV, A_NQKV, D);
    SEAM(1);
    if (IN(2)) p_rope_a(c, C, in[3], ws);
    SEAM(2);
    if (IN(3)) p_swa(c, in[4], ws);
    SEAM(3);
    if (IN(4)) GEMM_F32(OB, ws + WS_WO, D, D);
    SEAM(4);
    if (IN(5)) p_ln(c, in[0], C, in[9], in[10], out, XB);
    SEAM(5);
    if (IN(6)) GEMM_RELU2(XB, ws + WS_W1, FF, D);
    SEAM(6);
    if (IN(7)) GEMM_F32(HID, ws + WS_W2, D, FF);
    SEAM(7);
    if (IN(8)) p_ln(c, out, C, in[11], in[12], out, XB);
    SEAM(8);
    if (IN(9)) GEMM_F32(XB, ws + WS_WQKVB, B_NQKV, D);
    SEAM(9);
    if (IN(10)) p_rope_b(c, C, ws);
    SEAM(10);
    if (IN(11)) p_kbar(c, ws);
    SEAM(11);
    if (IN(12)) p_gate(c, ws);
    SEAM(12);
    if (IN(13)) p_moba_past(c, ws);
    SEAM(13);
    if (IN(14)) p_moba_own(c, ws);
    SEAM(14);
    if (IN(15)) GEMM_F32(OB, ws + WS_WOB, D, D);
    SEAM(15);
    if (IN(16)) p_ln(c, out, C, in[9] + D, in[10] + D, out, XB);
    SEAM(16);
    if (IN(17)) GEMM_RELU2(XB, ws + WS_W1 + 32 * MiB, FF, D);
    SEAM(17);
    if (IN(18)) GEMM_F32(HID, ws + WS_W2 + 32 * MiB, D, FF);
    SEAM(18);
    if (IN(19)) p_ln(c, out, C, in[11] + D, in[12] + D, out, XB);
#undef IN
#undef SEAM
}

extern "C" void kernel_launch(void* const* d_in, const int* in_sizes, int n_in, void* d_out, int out_size, void* d_ws, size_t ws_size, hipStream_t stream) {
    static int grid = 0;
    if (grid == 0) {
        if (n_in != 15 || out_size != S * D || ws_size < WS_END) { fprintf(stderr, "kernel_launch: unexpected sizes n_in %d out %d ws %zu\n", n_in, out_size, ws_size); grid = -1; return; }
        int dev = 0, cus = 0, per_cu = 0;
        if (hipGetDevice(&dev) != hipSuccess || hipDeviceGetAttribute(&cus, hipDeviceAttributeMultiprocessorCount, dev) != hipSuccess) { grid = -1; return; }
        if (hipFuncSetAttribute((const void*)fwd, hipFuncAttributeMaxDynamicSharedMemorySize, LDS_BYTES) != hipSuccess) { fprintf(stderr, "kernel_launch: hipFuncSetAttribute failed\n"); grid = -1; return; }
        if (hipOccupancyMaxActiveBlocksPerMultiprocessor(&per_cu, (const void*)fwd, NTHR, LDS_BYTES) != hipSuccess || per_cu < 1) { fprintf(stderr, "kernel_launch: occupancy query says %d\n", per_cu); }
        (void)hipGetLastError();
        grid = cus;
    }
    if (grid < 0) return;
    (void)hipMemsetAsync((char*)d_ws + WS_CTL, 0, CTL_ZERO_BYTES, stream);
    Args a{};
    for (int i = 0; i < 15; ++i) a.in[i] = (const float*)d_in[i];
    a.out = (float*)d_out; a.ws = (unsigned char*)d_ws;
    if (MK_N_LAUNCHES == 1) { a.ph_lo = 0; a.ph_hi = N_PHASES; a.li = 0; hipLaunchKernelGGL(fwd, dim3(grid), dim3(NTHR), LDS_BYTES, stream, a); }
    else { for (int p = 0; p < N_PHASES; ++p) { a.ph_lo = p; a.ph_hi = p + 1; a.li = 0; hipLaunchKernelGGL(fwd, dim3(grid), dim3(NTHR), LDS_BYTES, stream, a); } }
}
```
